# Optimizing an MI355X kernel written in HIP

```python
import math
import jax, jax.numpy as jnp
from jax import lax
import numpy as np

D_MODEL = 1024
BATCH = 8
SEQ = 4096
DEPTH = 1

N_MEM = 256
D_FF = 2816
D_POOL = 512
POOL_WINDOWS = (2, 4, 8, 16)
N_POOL_GROUPS = len(POOL_WINDOWS)
POOL_GROUP = D_POOL // N_POOL_GROUPS
D_SSM = 256
SSM_GROUP = 16
N_SSM_GROUPS = D_SSM // SSM_GROUP
SSM_STATE = 64
N_XHEADS = 4
XHEAD_DIM = D_MODEL // N_XHEADS
D_IN = D_POOL + D_SSM + 2 * D_MODEL
EPS = 1e-6

kernel_name = "hybrid_pool_s5_gated_encoder_layer"


def _rms_norm(v, g):
    vf = v.astype(jnp.float32)
    r = lax.rsqrt(jnp.mean(vf * vf, axis=-1, keepdims=True) + EPS)
    return (vf * r).astype(v.dtype) * g


def _swiglu(u, w_gate, w_up, w_down):
    return (jax.nn.silu(u @ w_gate) * (u @ w_up)) @ w_down


def _centred_pool_minus_self(v, window):
    L = v.shape[1]
    left = window // 2
    right = window - 1 - left
    c = jnp.concatenate([jnp.zeros_like(v[:, :1]), jnp.cumsum(v, axis=1)], axis=1)
    t = jnp.arange(L)
    lo = jnp.clip(t - left, 0, L)
    hi = jnp.clip(t + right + 1, 0, L)
    s = jnp.take(c, hi, axis=1) - jnp.take(c, lo, axis=1)
    cnt = (hi - lo).astype(jnp.float32)[None, :, None]
    return s / cnt - v


def _pool_mixer(p, pool_w, pool_scale):
    B_, L, _ = p.shape
    pf = p.astype(jnp.float32)
    groups = [
        _centred_pool_minus_self(pf[..., g * POOL_GROUP:(g + 1) * POOL_GROUP], w)
        for g, w in enumerate(POOL_WINDOWS)
    ]
    pooled = jnp.stack(groups, axis=2).astype(p.dtype)
    mixed = jnp.einsum('blgc,gcd->blgd', pooled, pool_w)
    return mixed.reshape(B_, L, D_POOL) * pool_scale


def _complex_linear_combine(e1, e2):
    a1r, a1i, b1r, b1i = e1
    a2r, a2i, b2r, b2i = e2
    ar = a2r * a1r - a2i * a1i
    ai = a2r * a1i + a2i * a1r
    br = a2r * b1r - a2i * b1i + b2r
    bi = a2r * b1i + a2i * b1r + b2i
    return (ar, ai, br, bi)


def _s5_bidirectional(s, a_re, a_im, log_dt, b_re, b_im, c_re, c_im, d_skip):
    B_, L, _ = s.shape
    uf = s.astype(jnp.float32).reshape(B_, L, N_SSM_GROUPS, SSM_GROUP)
    y = uf * d_skip.astype(jnp.float32).reshape(N_SSM_GROUPS, SSM_GROUP)
    for direction in range(2):
        ar = a_re[direction].astype(jnp.float32)
        ai = a_im[direction].astype(jnp.float32)
        dt = jnp.exp(log_dt[direction].astype(jnp.float32))[:, None]
        mag = jnp.exp(dt * ar)
        ang = dt * ai
        abr = mag * jnp.cos(ang)
        abi = mag * jnp.sin(ang)
        den = ar * ar + ai * ai
        nr = abr - 1.0
        qr = (nr * ar + abi * ai) / den
        qi = (abi * ar - nr * ai) / den
        br = b_re[direction].astype(jnp.float32)
        bi = b_im[direction].astype(jnp.float32)
        bbr = qr[..., None] * br - qi[..., None] * bi
        bbi = qr[..., None] * bi + qi[..., None] * br
        bur = jnp.einsum('gph,blgh->blgp', bbr, uf)
        bui = jnp.einsum('gph,blgh->blgp', bbi, uf)
        a_r = jnp.broadcast_to(abr, bur.shape)
        a_i = jnp.broadcast_to(abi, bur.shape)
        _, _, xr, xi = lax.associative_scan(
            _complex_linear_combine, (a_r, a_i, bur, bui), axis=1, reverse=(direction == 1))
        cr = c_re[direction].astype(jnp.float32)
        ci = c_im[direction].astype(jnp.float32)
        y = y + jnp.einsum('ghp,blgp->blgh', cr, xr) - jnp.einsum('ghp,blgp->blgh', ci, xi)
    return y.reshape(B_, L, D_SSM).astype(s.dtype)


def _cross_attention(u, mem_n, w_q, w_kv, w_xo):
    B_, L, _ = u.shape
    M = mem_n.shape[1]
    q = (u @ w_q).reshape(B_, L, N_XHEADS, XHEAD_DIM)
    kv = mem_n @ w_kv
    k = kv[..., :D_MODEL].reshape(B_, M, N_XHEADS, XHEAD_DIM)
    v = kv[..., D_MODEL:].reshape(B_, M, N_XHEADS, XHEAD_DIM)
    scores = jnp.einsum('blhd,bmhd->bhlm', q.astype(jnp.float32), k.astype(jnp.float32)) / math.sqrt(XHEAD_DIM)
    probs = jax.nn.softmax(scores, axis=-1).astype(u.dtype)
    o = jnp.einsum('bhlm,bmhd->blhd', probs, v).reshape(B_, L, D_MODEL)
    return o @ w_xo


def setup_inputs(seed: int = 0) -> dict:
    key = jax.random.key(seed)
    ks = iter(jax.random.split(key, 48))
    f32 = jnp.float32

    def nrm(shape, scale):
        return jax.random.normal(next(ks), shape, f32) * scale

    def gain(shape):
        return 1.0 + 0.02 * jax.random.normal(next(ks), shape, f32)

    L_ = DEPTH
    G, P, H = N_SSM_GROUPS, SSM_STATE, SSM_GROUP
    inp = {}
    inp['x'] = jax.random.normal(next(ks), (BATCH, SEQ, D_MODEL), f32)
    inp['mem'] = jax.random.normal(next(ks), (BATCH, N_MEM, D_MODEL), f32)
    inp['ffn1_norm'] = gain((L_, D_MODEL))
    inp['ffn1_w_gate'] = nrm((L_, D_MODEL, D_FF), D_MODEL ** -0.5)
    inp['ffn1_w_up'] = nrm((L_, D_MODEL, D_FF), D_MODEL ** -0.5)
    inp['ffn1_w_down'] = nrm((L_, D_FF, D_MODEL), D_FF ** -0.5)
    inp['mix_norm'] = gain((L_, D_MODEL))
    inp['w_in'] = nrm((L_, D_MODEL, D_IN), D_MODEL ** -0.5)
    inp['pool_w'] = nrm((L_, N_POOL_GROUPS, POOL_GROUP, POOL_GROUP), POOL_GROUP ** -0.5)
    inp['pool_scale'] = gain((L_, D_POOL))
    inp['w_pool_proj'] = nrm((L_, D_POOL, D_MODEL), D_POOL ** -0.5)
    a_re = -0.5 + 0.01 * jax.random.normal(next(ks), (L_, 2, G, P), f32)
    a_im = math.pi * jnp.arange(P, dtype=f32) + 0.01 * jax.random.normal(next(ks), (L_, 2, G, P), f32)
    inp['ssm_a_re'] = a_re
    inp['ssm_a_im'] = a_im
    inp['ssm_log_dt'] = jax.random.uniform(next(ks), (L_, 2, G), f32, math.log(1e-3), math.log(1e-1))
    inp['ssm_b_re'] = nrm((L_, 2, G, P, H), (2.0 * H) ** -0.5)
    inp['ssm_b_im'] = nrm((L_, 2, G, P, H), (2.0 * H) ** -0.5)
    inp['ssm_c_re'] = nrm((L_, 2, G, H, P), (2.0 * P) ** -0.5)
    inp['ssm_c_im'] = nrm((L_, 2, G, H, P), (2.0 * P) ** -0.5)
    inp['ssm_d'] = nrm((L_, D_SSM), 1.0)
    inp['w_glu_val'] = nrm((L_, D_SSM, D_MODEL), D_SSM ** -0.5)
    inp['w_glu_gate'] = nrm((L_, D_SSM, D_MODEL), D_SSM ** -0.5)
    inp['w_mix_out'] = nrm((L_, D_MODEL, D_MODEL), D_MODEL ** -0.5)
    inp['xattn_norm'] = gain((L_, D_MODEL))
    inp['mem_norm'] = gain((L_, D_MODEL))
    inp['w_q'] = nrm((L_, D_MODEL, D_MODEL), D_MODEL ** -0.5)
    inp['w_kv'] = nrm((L_, D_MODEL, 2 * D_MODEL), D_MODEL ** -0.5)
    inp['w_xo'] = nrm((L_, D_MODEL, D_MODEL), D_MODEL ** -0.5)
    inp['ffn2_norm'] = gain((L_, D_MODEL))
    inp['ffn2_w_gate'] = nrm((L_, D_MODEL, D_FF), D_MODEL ** -0.5)
    inp['ffn2_w_up'] = nrm((L_, D_MODEL, D_FF), D_MODEL ** -0.5)
    inp['ffn2_w_down'] = nrm((L_, D_FF, D_MODEL), D_FF ** -0.5)
    inp['final_norm'] = gain((D_MODEL,))
    return inp


def reference(x, mem, ffn1_norm, ffn1_w_gate, ffn1_w_up, ffn1_w_down,
              mix_norm, w_in, pool_w, pool_scale, w_pool_proj,
              ssm_a_re, ssm_a_im, ssm_log_dt, ssm_b_re, ssm_b_im, ssm_c_re, ssm_c_im, ssm_d,
              w_glu_val, w_glu_gate, w_mix_out,
              xattn_norm, mem_norm, w_q, w_kv, w_xo,
              ffn2_norm, ffn2_w_gate, ffn2_w_up, ffn2_w_down, final_norm):
    h = x
    for l in range(DEPTH):
        h = h + 0.5 * _swiglu(_rms_norm(h, ffn1_norm[l]), ffn1_w_gate[l], ffn1_w_up[l], ffn1_w_down[l])

        u = _rms_norm(h, mix_norm[l])
        proj = u @ w_in[l]
        p = proj[..., :D_POOL]
        s = proj[..., D_POOL:D_POOL + D_SSM]
        g_pool = proj[..., D_POOL + D_SSM:D_POOL + D_SSM + D_MODEL]
        g_ssm = proj[..., D_POOL + D_SSM + D_MODEL:]

        z_pool = _pool_mixer(p, pool_w[l], pool_scale[l]) @ w_pool_proj[l]
        y_ssm = jax.nn.gelu(_s5_bidirectional(s, ssm_a_re[l], ssm_a_im[l], ssm_log_dt[l],
                                              ssm_b_re[l], ssm_b_im[l], ssm_c_re[l], ssm_c_im[l], ssm_d[l]))
        z_ssm = (y_ssm @ w_glu_val[l]) * jax.nn.sigmoid(y_ssm @ w_glu_gate[l])

        merged = jax.nn.sigmoid(g_pool) * z_pool + jax.nn.sigmoid(g_ssm) * z_ssm
        h = h + merged @ w_mix_out[l]

        h = h + _cross_attention(_rms_norm(h, xattn_norm[l]), _rms_norm(mem, mem_norm[l]),
                                 w_q[l], w_kv[l], w_xo[l])

        h = h + 0.5 * _swiglu(_rms_norm(h, ffn2_norm[l]), ffn2_w_gate[l], ffn2_w_up[l], ffn2_w_down[l])
    return _rms_norm(h, final_norm)
```

```cpp
#include <hip/hip_runtime.h>
#include <hip/hip_cooperative_groups.h>
#include <cstdio>
#include <cstdint>
namespace cg = cooperative_groups;

#ifndef MK_SINGLE
#define MK_SINGLE 1
#endif

#define LAS __attribute__((address_space(3)))
typedef unsigned short bf16_t;
typedef short bf16x8 __attribute__((ext_vector_type(8)));
typedef float f32x4 __attribute__((ext_vector_type(4)));
typedef float f32x2 __attribute__((ext_vector_type(2)));
typedef unsigned u32x4 __attribute__((ext_vector_type(4)));
typedef unsigned u32x2 __attribute__((ext_vector_type(2)));

constexpr int MTOK = 32768, DM = 1024, FF = 2816, DIN = 2816, SEQL = 4096, NB = 8, NMEM = 256, MEMROWS = 2048;
constexpr int DPOOL = 512, DSSM = 256, NG = 16, CH = 64  , NCH = 512  , UXLD = 1280;
constexpr float EPS = 1e-6f;

constexpr size_t MiB = 1u << 20;
constexpr size_t WS_SS = 0;
constexpr size_t WS_PW = 10 * MiB;
constexpr size_t WS_BBAR = 11 * MiB + 256 * 1024;
constexpr size_t WS_KT = 12 * MiB;
constexpr size_t WS_W1GU = 14 * MiB;
constexpr size_t WS_W1D = WS_W1GU + 11 * MiB;
constexpr size_t WS_W2GU = WS_W1D + 5 * MiB + 512 * 1024;
constexpr size_t WS_W2D = WS_W2GU + 11 * MiB;
constexpr size_t WS_WIN = WS_W2D + 5 * MiB + 512 * 1024;
constexpr size_t WS_WPE = WS_WIN + 5 * MiB + 512 * 1024;
constexpr size_t WS_WGLU = WS_WPE + 1 * MiB;
constexpr size_t WS_WMO = WS_WGLU + 1 * MiB;
constexpr size_t WS_WQ = WS_WMO + 2 * MiB;
constexpr size_t WS_WKV = WS_WQ + 2 * MiB;
constexpr size_t WS_WXO = WS_WKV + 4 * MiB;
constexpr size_t WS_SE = WS_WXO + 2 * MiB;
constexpr size_t WS_SY = WS_SE + 8 * MiB;
constexpr size_t WS_MEMN = WS_SY + 40 * MiB;
constexpr size_t WS_KB = WS_MEMN + 4 * MiB;
constexpr size_t WS_VT = WS_KB + 4 * MiB;
constexpr size_t WS_R1 = WS_VT + 4 * MiB;
constexpr size_t WS_HB = WS_R1 + 64 * MiB;
constexpr size_t WS_R2 = WS_HB + 176 * MiB;
constexpr size_t WS_R3 = WS_R2 + 76 * MiB;
constexpr size_t WS_END = WS_R3 + 64 * MiB;
static_assert(WS_END <= 512 * MiB, "workspace map");

__device__ __forceinline__ unsigned cvt_pk_bf16(float lo, float hi) { unsigned r; asm volatile("v_cvt_pk_bf16_f32 %0, %1, %2" : "=v"(r) : "v"(lo), "v"(hi)); return r; }
__device__ __forceinline__ float bf_lo(unsigned w) { return __uint_as_float(w << 16); }
__device__ __forceinline__ float bf_hi(unsigned w) { return __uint_as_float(w & 0xffff0000u); }
__device__ __forceinline__ float wave_sum(float v) {
#pragma unroll
    for (int o = 1; o < 64; o <<= 1) v += __shfl_xor(v, o);
    return v;
}
__device__ __forceinline__ float sigmoid_f(float v) { return __builtin_amdgcn_rcpf(1.0f + __builtin_amdgcn_exp2f(-1.4426950408889634f * v)); }
__device__ __forceinline__ float gelu_tanh_f(float x) { const float z = 1.5957691216057308f * (x + 0.044715f * x * x * x); return x * sigmoid_f(z); }
__device__ __forceinline__ float row_rstd(const float* ss, int row) {
    const f32x4* p = (const f32x4*)(ss + (size_t)row * 16);
    const f32x4 a = p[0], b = p[1], c = p[2], d = p[3];
    const float s = ((a.x + a.y) + (a.z + a.w)) + ((b.x + b.y) + (b.z + b.w)) + ((c.x + c.y) + (c.z + c.w)) + ((d.x + d.y) + (d.z + d.w));
    return rsqrtf(s * (1.0f / 1024.0f) + EPS);
}
#define LDS_WAIT() asm volatile("s_waitcnt lgkmcnt(0)" ::: "memory")

namespace pg8 {
constexpr int BM = 256, BK = 64, HALF = 128, HTB = HALF * BK * 2, STAGE_BYTES = 8 * HTB, NXCD = 8, WGM = 8;
__host__ __device__ __forceinline__ int lds_byte(int r, int c) { const int st = (r >> 4) * 2 + (c >> 5), rr = r & 15, cc = c & 31, ob = rr * 64 + cc * 2; return st * 1024 + (ob ^ (((ob >> 9) & 1) << 5)); }
__host__ __device__ __forceinline__ void stage_rc(int b, int& R, int& C) { const int st = b / 1024, sb = b % 1024, swz = sb ^ (((sb >> 9) & 1) << 5); R = (st >> 1) * 16 + swz / 64; C = (st & 1) * 32 + (swz % 64) / 2; }
__host__ __device__ __forceinline__ int perm32(int rho) { const int n = rho >> 4, i = rho & 15; return 8 * (i >> 2) + 4 * n + (i & 3); }

struct Unit { int pm, pn, za, zb; };
struct Gemm { const bf16_t* A; const bf16_t* Bt; int lda, ldb, K; size_t sAz, sBz; };

struct StaticOrder {
    int nM, nN, nwg, G, c;
    __device__ void init(int M, int N, int G_, int c_) { nM = M / BM; nN = N / BM; nwg = nM * nN; G = G_; c = c_; }
    __device__ bool next(int i, Unit& u) const {
        if (c < 0) return false;
        const long L = (long)i * G + c; if (L >= nwg) return false;
        int wgid = (int)L; { const int q = nwg / NXCD, r = nwg % NXCD, xcd = wgid % NXCD, off = wgid / NXCD; wgid = (xcd < r ? xcd * (q + 1) : r * (q + 1) + (xcd - r) * q) + off; }
        const int nig = WGM * nN, gid = wgid / nig, fm = gid * WGM, gsz = (nM - fm) < WGM ? (nM - fm) : WGM;
        u.pm = fm + ((wgid % nig) % gsz); u.pn = (wgid % nig) / gsz; u.za = 0; u.zb = 0; return true;
    }
};
template <int KIND> struct GenOrder {
    int n, nM, nN, G, c;
    __device__ bool next(int i, Unit& u) const {
        if (c < 0) return false;
        const int L = i * G + c; if (L >= n) return false;
        if (KIND == 0) { const int per = nM * nN, z = L / per, rem = L % per; u.pm = rem % nM; u.pn = rem / nM; u.za = z; u.zb = z; }
        else if (KIND == 1) { const int h = L & 3, pm = L >> 2; u.pm = pm; u.pn = pm >> 4; u.za = h; u.zb = h; }
        else { const int h = L & 3, pm = L >> 2; u.pm = pm; u.pn = (pm >> 4) * 4 + h; u.za = h; u.zb = 0; }
        return true;
    }
};
struct OneUnit { Unit u; bool valid; __device__ bool next(int i, Unit& o) const { if (i != 0 || !valid) return false; o = u; return true; } };

__device__ __forceinline__ const char* aptr(const Gemm& g, const Unit& u) { return (const char*)g.A + ((size_t)u.pm * BM * g.lda + (size_t)u.za * g.sAz) * 2; }
__device__ __forceinline__ const char* bptr(const Gemm& g, const Unit& u) { return (const char*)g.Bt + ((size_t)u.pn * BM * g.ldb + (size_t)u.zb * g.sBz) * 2; }

template <class Epi, class Sched, bool ALIGN_EPI>
__device__ __forceinline__ void gemm_phase(LAS unsigned char* lds, const Gemm g, const Sched& S, const Epi& E) {
    const int tid = threadIdx.x, wid = __builtin_amdgcn_readfirstlane(tid >> 6), lane = tid & 63, wr = wid >> 2, wc = wid & 3, fr = lane & 15, fq = lane >> 4;
    const int K = g.K, nt = K / BK;
    unsigned voffA[2], voffB[2];
#pragma unroll
    for (int i = 0; i < 2; ++i) { int R, C; stage_rc(tid * 16 + i * 8192, R, C); const int Rb = Epi::PERM ? ((R & ~31) + perm32(R & 31)) : R;
        voffA[i] = (unsigned)(R * g.lda + C) * 2u; voffB[i] = (unsigned)(Rb * g.ldb + C) * 2u; }
    const size_t kstep = (size_t)(BK * 2);
    const size_t hstepA = (size_t)HALF * g.lda * 2, hstepB = (size_t)HALF * g.ldb * 2;
    const unsigned ldsw = (unsigned)wid * 1024u;
    const int aoff = lds_byte(wr * 64 + fr, fq * 8), boff = lds_byte(wc * 32 + fr, fq * 8);
#define PG8_SA(b, h) (((b) * 2 + (h)) * HTB)
#define PG8_SB(b, h) ((4 + (b) * 2 + (h)) * HTB)
#define PG8_STAGE(bufoff, gbase, voff) do { _Pragma("unroll") for (int _i = 0; _i < 2; ++_i) \
        __builtin_amdgcn_global_load_lds((const unsigned*)((const char*)(gbase) + (voff)[_i]), (LAS unsigned*)(lds + (bufoff) + ldsw + _i * 8192), 16, 0, 0); } while (0)
#define PG8_LDA(dst, b, h) do { _Pragma("unroll") for (int m = 0; m < 4; ++m) _Pragma("unroll") for (int k = 0; k < 2; ++k) dst[m][k] = *(const LAS bf16x8*)(lds + PG8_SA(b, h) + aoff + m * 2048 + k * 1024); } while (0)
#define PG8_LDB(dst, b, h) do { _Pragma("unroll") for (int n = 0; n < 2; ++n) _Pragma("unroll") for (int k = 0; k < 2; ++k) dst[n][k] = *(const LAS bf16x8*)(lds + PG8_SB(b, h) + boff + n * 2048 + k * 1024); } while (0)
#define PG8_MMA(ai, bj, At, Bt) do { __builtin_amdgcn_s_setprio(1); _Pragma("unroll") for (int m = 0; m < 4; ++m) _Pragma("unroll") for (int n = 0; n < 2; ++n) _Pragma("unroll") for (int k = 0; k < 2; ++k) \
        acc[ai][bj][m][n] = __builtin_amdgcn_mfma_f32_16x16x32_bf16(Bt[n][k], At[m][k], acc[ai][bj][m][n], 0, 0, 0); __builtin_amdgcn_s_setprio(0); } while (0)
#define PG8_WAIT_V(n) asm volatile("s_waitcnt vmcnt(" #n ")" ::: "memory")
#define PG8_WAIT_L(n) asm volatile("s_waitcnt lgkmcnt(" #n ")" ::: "memory")
#define PG8_BAR __builtin_amdgcn_s_barrier()
#define PG8_SCHED __builtin_amdgcn_sched_barrier(0)
    Unit cur, nxt; int ui = 0;
    if (!S.next(0, cur)) return;
    f32x4 acc[2][2][4][2];
#pragma unroll
    for (int a = 0; a < 2; ++a)
#pragma unroll
        for (int b = 0; b < 2; ++b)
#pragma unroll
            for (int m = 0; m < 4; ++m)
#pragma unroll
                for (int n = 0; n < 2; ++n) acc[a][b][m][n] = (f32x4){0.f, 0.f, 0.f, 0.f};
    bf16x8 At[4][2], B0[2][2], B1[2][2];
    const char* cA = aptr(g, cur); const char* cB = bptr(g, cur);
    PG8_STAGE(PG8_SB(0, 0), cB, voffB); PG8_STAGE(PG8_SB(0, 1), cB + hstepB, voffB); PG8_STAGE(PG8_SA(0, 0), cA, voffA); PG8_STAGE(PG8_SA(0, 1), cA + hstepA, voffA);
    if (wr == 1) PG8_BAR;
    PG8_WAIT_V(2); PG8_BAR;
    PG8_STAGE(PG8_SB(1, 0), cB + kstep, voffB); PG8_STAGE(PG8_SA(1, 0), cA + kstep, voffA); PG8_STAGE(PG8_SB(1, 1), cB + hstepB + kstep, voffB);
    PG8_WAIT_V(6); PG8_BAR;
    for (;;) {
        const bool has_next = S.next(ui + 1, nxt);
        const char* nA = has_next ? aptr(g, nxt) : cA; const char* nB = has_next ? bptr(g, nxt) : cB;
#pragma nounroll
        for (int t = 0; t < nt; t += 2) {
            const bool last = (t == nt - 2);
            const char* a1 = cA + (size_t)(t + 1) * kstep;
            const char* a2 = last ? nA : cA + (size_t)(t + 2) * kstep; const char* b2 = last ? nB : cB + (size_t)(t + 2) * kstep;
            const char* a3 = a2 + kstep; const char* b3 = b2 + kstep;
            PG8_LDB(B0, 0, 0); PG8_LDB(B1, 0, 1); PG8_SCHED; PG8_LDA(At, 0, 0); PG8_STAGE(PG8_SA(1, 1), a1 + hstepA, voffA);
            PG8_WAIT_V(8); PG8_WAIT_L(0); PG8_BAR; PG8_MMA(0, 0, At, B0); PG8_MMA(0, 1, At, B1); PG8_BAR; PG8_SCHED;
            PG8_LDA(At, 0, 1); PG8_STAGE(PG8_SB(0, 0), b2, voffB); PG8_STAGE(PG8_SB(0, 1), b2 + hstepB, voffB); PG8_STAGE(PG8_SA(0, 0), a2, voffA);
            PG8_WAIT_V(8); PG8_WAIT_L(0); PG8_BAR; PG8_MMA(1, 0, At, B0); PG8_MMA(1, 1, At, B1); PG8_BAR; PG8_SCHED;
            PG8_LDB(B0, 1, 0); PG8_LDB(B1, 1, 1); PG8_SCHED; PG8_LDA(At, 1, 0); PG8_STAGE(PG8_SA(0, 1), a2 + hstepA, voffA);
            PG8_WAIT_V(8); PG8_WAIT_L(0); PG8_BAR; PG8_MMA(0, 0, At, B0); PG8_MMA(0, 1, At, B1); PG8_BAR; PG8_SCHED;
            PG8_LDA(At, 1, 1); PG8_STAGE(PG8_SB(1, 0), b3, voffB); PG8_STAGE(PG8_SB(1, 1), b3 + hstepB, voffB); PG8_STAGE(PG8_SA(1, 0), a3, voffA);
            PG8_WAIT_V(8); PG8_WAIT_L(0); PG8_BAR; PG8_MMA(1, 0, At, B0); PG8_MMA(1, 1, At, B1); PG8_BAR; PG8_SCHED;
        }
        if constexpr (ALIGN_EPI) { if (wr == 0) PG8_BAR; }
        if constexpr (!Epi::AFTER_DRAIN) { E(acc, cur, wr, wc, fr, fq); }
        if (!has_next) break;
#pragma unroll
        for (int a = 0; a < 2; ++a)
#pragma unroll
            for (int b = 0; b < 2; ++b)
#pragma unroll
                for (int m = 0; m < 4; ++m)
#pragma unroll
                    for (int n = 0; n < 2; ++n) acc[a][b][m][n] = (f32x4){0.f, 0.f, 0.f, 0.f};
        cur = nxt; cA = nA; cB = nB; ++ui;
        if constexpr (ALIGN_EPI) { if (wr == 1) PG8_BAR; }
    }
    PG8_WAIT_V(0);
    if constexpr (!ALIGN_EPI) { if (wr == 0) PG8_BAR; }
    PG8_BAR;
    if constexpr (Epi::AFTER_DRAIN) { E.fused(acc, cur, wr, wc, fr, fq, lds, wid, lane); }
#undef PG8_SA
#undef PG8_SB
#undef PG8_STAGE
#undef PG8_LDA
#undef PG8_LDB
#undef PG8_MMA
#undef PG8_WAIT_V
#undef PG8_WAIT_L
#undef PG8_BAR
#undef PG8_SCHED
}

typedef const f32x4 (&AccRef)[2][2][4][2];

struct EpiSwiGLU {
    static constexpr bool PERM = true, AFTER_DRAIN = false;
    bf16_t* H; const float* ss;
    __device__ __forceinline__ void operator()(AccRef acc, const Unit& u, int wr, int wc, int fr, int fq) const {
        const int row0 = u.pm * BM + wr * 64 + fr, col = u.pn * 128 + wc * 32 + 8 * fq;
#pragma unroll
        for (int ai = 0; ai < 2; ++ai)
#pragma unroll
            for (int m = 0; m < 4; ++m) {
                const int row = row0 + ai * HALF + m * 16; const float r = row_rstd(ss, row);
                float o[8];
#pragma unroll
                for (int n = 0; n < 2; ++n)
#pragma unroll
                    for (int j = 0; j < 4; ++j) { const float gv = acc[ai][0][m][n][j] * r, uv = acc[ai][1][m][n][j] * r; o[n * 4 + j] = gv * sigmoid_f(gv) * uv; }
                u32x4 w; w.x = cvt_pk_bf16(o[0], o[1]); w.y = cvt_pk_bf16(o[2], o[3]); w.z = cvt_pk_bf16(o[4], o[5]); w.w = cvt_pk_bf16(o[6], o[7]);
                *(u32x4*)(H + (size_t)row * FF + col) = w;
                asm volatile("" ::: "memory");
            }
    }
};
template <bool WRITE_HB> struct EpiResid {
    static constexpr bool PERM = true, AFTER_DRAIN = false;
    const float* src; float* dst; bf16_t* hb; float* ss; float alpha;
    __device__ __forceinline__ void operator()(AccRef acc, const Unit& u, int wr, int wc, int fr, int fq) const {
        const int row0 = u.pm * BM + wr * 64 + fr, col0 = u.pn * BM + wc * 32 + 8 * fq;
#pragma unroll
        for (int ai = 0; ai < 2; ++ai)
#pragma unroll
            for (int m = 0; m < 4; ++m) {
                const int row = row0 + ai * HALF + m * 16; float q = 0.f;
#pragma unroll
                for (int bj = 0; bj < 2; ++bj) {
                    const size_t off = (size_t)row * DM + col0 + bj * HALF;
                    const f32x4 b0 = *(const f32x4*)(src + off), b1 = *(const f32x4*)(src + off + 4);
                    const f32x4 v0 = b0 + acc[ai][bj][m][0] * alpha, v1 = b1 + acc[ai][bj][m][1] * alpha;
                    *(f32x4*)(dst + off) = v0; *(f32x4*)(dst + off + 4) = v1;
                    q += (v0[0] * v0[0] + v0[1] * v0[1]) + (v0[2] * v0[2] + v0[3] * v0[3]) + (v1[0] * v1[0] + v1[1] * v1[1]) + (v1[2] * v1[2] + v1[3] * v1[3]);
                    if (WRITE_HB) { u32x4 w; w.x = cvt_pk_bf16(v0[0], v0[1]); w.y = cvt_pk_bf16(v0[2], v0[3]); w.z = cvt_pk_bf16(v1[0], v1[1]); w.w = cvt_pk_bf16(v1[2], v1[3]); *(u32x4*)(hb + off) = w; }
                }
                q += __shfl_xor(q, 16); q += __shfl_xor(q, 32);
                if (fq == 0) ss[(size_t)row * 16 + u.pn * 4 + wc] = q;
                asm volatile("" ::: "memory");
            }
    }
};
struct EpiWin {
    static constexpr bool PERM = true, AFTER_DRAIN = false;
    bf16_t* p; bf16_t* ux; bf16_t* sg; const float* ss;
    __device__ __forceinline__ void operator()(AccRef acc, const Unit& u, int wr, int wc, int fr, int fq) const {
        const int row0 = u.pm * BM + wr * 64 + fr, tc0 = wc * 32 + 8 * fq;
#pragma unroll
        for (int ai = 0; ai < 2; ++ai)
#pragma unroll
            for (int m = 0; m < 4; ++m) {
                const int row = row0 + ai * HALF + m * 16; const float r = row_rstd(ss, row);
#pragma unroll
                for (int bj = 0; bj < 2; ++bj) {
                    const int tc = tc0 + bj * HALF;
                    f32x4 v0 = acc[ai][bj][m][0] * r, v1 = acc[ai][bj][m][1] * r;
                    bf16_t* dst;
                    if (u.pn < 2) dst = p + (size_t)row * DPOOL + u.pn * BM + tc;
                    else if (u.pn == 2) { const int gi = tc >> 4, h0 = tc & 15; dst = ux + ((size_t)(gi * NCH + (row >> 6))) * UXLD + (row & 63) * 16 + h0; }
                    else {
                        dst = sg + (size_t)row * 2048 + (u.pn - 3) * BM + tc;
#pragma unroll
                        for (int j = 0; j < 4; ++j) { v0[j] = sigmoid_f(v0[j]); v1[j] = sigmoid_f(v1[j]); }
                    }
                    u32x4 w; w.x = cvt_pk_bf16(v0[0], v0[1]); w.y = cvt_pk_bf16(v0[2], v0[3]); w.z = cvt_pk_bf16(v1[0], v1[1]); w.w = cvt_pk_bf16(v1[2], v1[3]);
                    *(u32x4*)dst = w;
                }
                asm volatile("" ::: "memory");
            }
    }
};
struct EpiPool {
    static constexpr bool PERM = true, AFTER_DRAIN = false;
    bf16_t* zp; const bf16_t* sg;
    __device__ __forceinline__ void operator()(AccRef acc, const Unit& u, int wr, int wc, int fr, int fq) const {
        const int row0 = u.pm * BM + wr * 64 + fr, col0 = u.pn * BM + wc * 32 + 8 * fq;
#pragma unroll
        for (int ai = 0; ai < 2; ++ai)
#pragma unroll
            for (int m = 0; m < 4; ++m) {
                const int row = row0 + ai * HALF + m * 16;
#pragma unroll
                for (int bj = 0; bj < 2; ++bj) {
                    const int col = col0 + bj * HALF;
                    const u32x4 s = *(const u32x4*)(sg + (size_t)row * 2048 + col);
                    const f32x4 a0 = acc[ai][bj][m][0], a1 = acc[ai][bj][m][1];
                    u32x4 w; w.x = cvt_pk_bf16(a0[0] * bf_lo(s.x), a0[1] * bf_hi(s.x)); w.y = cvt_pk_bf16(a0[2] * bf_lo(s.y), a0[3] * bf_hi(s.y));
                    w.z = cvt_pk_bf16(a1[0] * bf_lo(s.z), a1[1] * bf_hi(s.z)); w.w = cvt_pk_bf16(a1[2] * bf_lo(s.w), a1[3] * bf_hi(s.w));
                    *(u32x4*)(zp + (size_t)row * DM + col) = w;
                }
                asm volatile("" ::: "memory");
            }
    }
};
struct EpiGLU {
    static constexpr bool PERM = true, AFTER_DRAIN = false;
    bf16_t* merged; const bf16_t* zp; const bf16_t* sg;
    __device__ __forceinline__ void operator()(AccRef acc, const Unit& u, int wr, int wc, int fr, int fq) const {
        const int row0 = u.pm * BM + wr * 64 + fr, col = u.pn * 128 + wc * 32 + 8 * fq;
#pragma unroll
        for (int ai = 0; ai < 2; ++ai)
#pragma unroll
            for (int m = 0; m < 4; ++m) {
                const int row = row0 + ai * HALF + m * 16;
                const u32x4 z = *(const u32x4*)(zp + (size_t)row * DM + col);
                const u32x4 s = *(const u32x4*)(sg + (size_t)row * 2048 + 1024 + col);
                float o[8];
#pragma unroll
                for (int n = 0; n < 2; ++n)
#pragma unroll
                    for (int j = 0; j < 4; ++j) o[n * 4 + j] = acc[ai][0][m][n][j] * sigmoid_f(acc[ai][1][m][n][j]);
                u32x4 w;
                w.x = cvt_pk_bf16(bf_lo(z.x) + bf_lo(s.x) * o[0], bf_hi(z.x) + bf_hi(s.x) * o[1]);
                w.y = cvt_pk_bf16(bf_lo(z.y) + bf_lo(s.y) * o[2], bf_hi(z.y) + bf_hi(s.y) * o[3]);
                w.z = cvt_pk_bf16(bf_lo(z.z) + bf_lo(s.z) * o[4], bf_hi(z.z) + bf_hi(s.z) * o[5]);
                w.w = cvt_pk_bf16(bf_lo(z.w) + bf_lo(s.w) * o[6], bf_hi(z.w) + bf_hi(s.w) * o[7]);
                *(u32x4*)(merged + (size_t)row * DM + col) = w;
                asm volatile("" ::: "memory");
            }
    }
};
template <bool HAS_SS> struct EpiBf16 {
    static constexpr bool PERM = true, AFTER_DRAIN = false;
    bf16_t* out; int ld, rowpn, colpn, colza; const float* ss; float scale;
    __device__ __forceinline__ void operator()(AccRef acc, const Unit& u, int wr, int wc, int fr, int fq) const {
        const int row0 = u.pm * BM + wr * 64 + fr + u.pn * rowpn, col0 = u.pn * colpn + u.za * colza + wc * 32 + 8 * fq;
        bf16_t* ob = out + (size_t)row0 * ld + col0;
#pragma unroll
        for (int ai = 0; ai < 2; ++ai)
#pragma unroll
            for (int m = 0; m < 4; ++m) {
                float r = scale;
                if (HAS_SS) r *= row_rstd(ss, u.pm * BM + wr * 64 + fr + ai * HALF + m * 16);
#pragma unroll
                for (int bj = 0; bj < 2; ++bj) {
                    const f32x4 v0 = acc[ai][bj][m][0] * r, v1 = acc[ai][bj][m][1] * r;
                    u32x4 w; w.x = cvt_pk_bf16(v0[0], v0[1]); w.y = cvt_pk_bf16(v0[2], v0[3]); w.z = cvt_pk_bf16(v1[0], v1[1]); w.w = cvt_pk_bf16(v1[2], v1[3]);
                    *(u32x4*)(ob + (size_t)(ai * HALF + m * 16) * ld + bj * HALF) = w;
                }
                if (m & 1) asm volatile("" ::: "memory");
            }
    }
};
struct EpiStates {
    static constexpr bool PERM = false, AFTER_DRAIN = false;
    float* st;
    __device__ __forceinline__ void operator()(AccRef acc, const Unit& u, int wr, int wc, int fr, int fq) const {
        const int row0 = u.pm * BM + wr * 64 + fr, col0 = wc * 32 + 4 * fq;
#pragma unroll
        for (int ai = 0; ai < 2; ++ai)
#pragma unroll
            for (int m = 0; m < 4; ++m) {
                const int row = row0 + ai * HALF + m * 16;
#pragma unroll
                for (int bj = 0; bj < 2; ++bj)
#pragma unroll
                    for (int n = 0; n < 2; ++n) *(f32x4*)(st + ((size_t)(u.za * NCH + row)) * 256 + col0 + bj * HALF + n * 16) = acc[ai][bj][m][n];
            }
    }
};
struct EpiSsmY {
    static constexpr bool PERM = true, AFTER_DRAIN = false;
    bf16_t* yact;
    __device__ __forceinline__ void operator()(AccRef acc, const Unit& u, int wr, int wc, int fr, int fq) const {
        const int row0 = u.pm * BM + wr * 64 + fr, c0 = u.pn * BM + wc * 32 + 8 * fq;
#pragma unroll
        for (int ai = 0; ai < 2; ++ai)
#pragma unroll
            for (int m = 0; m < 4; ++m) {
                const int row = row0 + ai * HALF + m * 16;
#pragma unroll
                for (int bj = 0; bj < 2; ++bj) {
                    const int c = c0 + bj * HALF, t = c >> 4, h0 = c & 15;
                    const f32x4 a0 = acc[ai][bj][m][0], a1 = acc[ai][bj][m][1];
                    u32x4 w; w.x = cvt_pk_bf16(gelu_tanh_f(a0[0]), gelu_tanh_f(a0[1])); w.y = cvt_pk_bf16(gelu_tanh_f(a0[2]), gelu_tanh_f(a0[3]));
                    w.z = cvt_pk_bf16(gelu_tanh_f(a1[0]), gelu_tanh_f(a1[1])); w.w = cvt_pk_bf16(gelu_tanh_f(a1[2]), gelu_tanh_f(a1[3]));
                    *(u32x4*)(yact + ((size_t)row * CH + t) * DSSM + u.za * 16 + h0) = w;
                }
                asm volatile("" ::: "memory");
            }
    }
};
struct EpiSoftmax {
    static constexpr bool PERM = true, AFTER_DRAIN = true;
    bf16_t* P;
    __device__ __forceinline__ void fused(f32x4 (&acc)[2][2][4][2], const Unit& u, int wr, int wc, int fr, int fq, LAS unsigned char* lds, int wid, int lane) const {
        LAS float* red = (LAS float*)lds; LAS float* red2 = (LAS float*)(lds + 4096);
#pragma unroll
        for (int ai = 0; ai < 2; ++ai)
#pragma unroll
            for (int m = 0; m < 4; ++m) {
                float mx = -3.0e38f;
#pragma unroll
                for (int bj = 0; bj < 2; ++bj)
#pragma unroll
                    for (int n = 0; n < 2; ++n)
#pragma unroll
                        for (int j = 0; j < 4; ++j) mx = fmaxf(mx, acc[ai][bj][m][n][j]);
                mx = fmaxf(mx, __shfl_xor(mx, 16)); mx = fmaxf(mx, __shfl_xor(mx, 32));
                if (fq == 0) red[(ai * HALF + wr * 64 + m * 16 + fr) * 4 + wc] = mx;
            }
        __syncthreads();
#pragma unroll
        for (int ai = 0; ai < 2; ++ai)
#pragma unroll
            for (int m = 0; m < 4; ++m) {
                const int r = ai * HALF + wr * 64 + m * 16 + fr;
                const f32x4 q = *(const LAS f32x4*)(red + r * 4);
                const float mx = fmaxf(fmaxf(q[0], q[1]), fmaxf(q[2], q[3])) * 1.4426950408889634f; float s = 0.f;
#pragma unroll
                for (int bj = 0; bj < 2; ++bj)
#pragma unroll
                    for (int n = 0; n < 2; ++n)
#pragma unroll
                        for (int j = 0; j < 4; ++j) { const float e = __builtin_amdgcn_exp2f(acc[ai][bj][m][n][j] * 1.4426950408889634f - mx); acc[ai][bj][m][n][j] = e; s += e; }
                s += __shfl_xor(s, 16); s += __shfl_xor(s, 32);
                if (fq == 0) red2[r * 4 + wc] = s;
            }
        __syncthreads();
#pragma unroll
        for (int ai = 0; ai < 2; ++ai)
#pragma unroll
            for (int m = 0; m < 4; ++m) {
                const int r = ai * HALF + wr * 64 + m * 16 + fr;
                const f32x4 q = *(const LAS f32x4*)(red2 + r * 4);
                const float inv = 1.0f / ((q[0] + q[1]) + (q[2] + q[3]));
#pragma unroll
                for (int bj = 0; bj < 2; ++bj) {
                    const f32x4 v0 = acc[ai][bj][m][0] * inv, v1 = acc[ai][bj][m][1] * inv;
                    u32x4 w; w.x = cvt_pk_bf16(v0[0], v0[1]); w.y = cvt_pk_bf16(v0[2], v0[3]); w.z = cvt_pk_bf16(v1[0], v1[1]); w.w = cvt_pk_bf16(v1[2], v1[3]);
                    *(u32x4*)(P + (size_t)(u.pm * BM + r) * DM + u.za * 256 + bj * HALF + wc * 32 + 8 * fq) = w;
                }
            }
        __syncthreads();
    }
};
}

__device__ __forceinline__ void tr_item(const float* W, int N, bf16_t* WT, int ldo, int out_row0, const float* gk, LAS float* scr, int k0, int n0, int lane) {
#pragma unroll 8
    for (int i = 0; i < 32; ++i) { const int kk = 2 * i + (lane >> 5); float v = W[(size_t)(k0 + kk) * N + n0 + (lane & 31)]; if (gk) v *= gk[k0 + kk]; scr[kk * 33 + (lane & 31)] = v; }
    LDS_WAIT();
    const int c = lane & 7;
#pragma unroll
    for (int j = 0; j < 4; ++j) { const int n = (lane >> 3) + 8 * j; const LAS float* s = scr + (8 * c) * 33 + n;
        u32x4 o; o.x = cvt_pk_bf16(s[0 * 33], s[1 * 33]); o.y = cvt_pk_bf16(s[2 * 33], s[3 * 33]); o.z = cvt_pk_bf16(s[4 * 33], s[5 * 33]); o.w = cvt_pk_bf16(s[6 * 33], s[7 * 33]);
        *(u32x4*)(WT + (size_t)(out_row0 + n) * ldo + k0 + 8 * c) = o; }
    LDS_WAIT();
}

struct Args { const float* in[32]; float* out; unsigned char* ws; int ph_lo, ph_hi; };
constexpr int NPHASE = 16;

__global__ void __launch_bounds__(512, 2) mk_fwd(Args a) {
    extern __shared__ __attribute__((aligned(16))) unsigned char lds_raw[];
    LAS unsigned char* lds = (LAS unsigned char*)lds_raw;
    cg::grid_group grid = cg::this_grid();
    const int tid = threadIdx.x, lane = tid & 63, wave = __builtin_amdgcn_readfirstlane(tid >> 6);
    const int G = gridDim.x, bx = blockIdx.x;
    const int gtid = bx * 512 + tid, NT = G * 512, gw = bx * 8 + wave, NGW = G * 8;
    unsigned char* ws = a.ws;
    float* ss0 = (float*)(ws + WS_SS); float* ss1 = ss0 + (size_t)MTOK * 16; float* ss2 = ss1 + (size_t)MTOK * 16; float* ss3 = ss2 + (size_t)MTOK * 16; float* ss4 = ss3 + (size_t)MTOK * 16;
    f32x2* pw = (f32x2*)(ws + WS_PW); f32x2* bbar = (f32x2*)(ws + WS_BBAR); float* kt = (float*)(ws + WS_KT);
    bf16_t* w1gu = (bf16_t*)(ws + WS_W1GU); bf16_t* w1d = (bf16_t*)(ws + WS_W1D); bf16_t* w2gu = (bf16_t*)(ws + WS_W2GU); bf16_t* w2d = (bf16_t*)(ws + WS_W2D);
    bf16_t* win = (bf16_t*)(ws + WS_WIN); bf16_t* wpe = (bf16_t*)(ws + WS_WPE); bf16_t* wglu = (bf16_t*)(ws + WS_WGLU); bf16_t* wmo = (bf16_t*)(ws + WS_WMO);
    bf16_t* wq = (bf16_t*)(ws + WS_WQ); bf16_t* wkv = (bf16_t*)(ws + WS_WKV); bf16_t* wxo = (bf16_t*)(ws + WS_WXO);
    bf16_t* sE = (bf16_t*)(ws + WS_SE); bf16_t* sY = (bf16_t*)(ws + WS_SY);
    bf16_t* memn = (bf16_t*)(ws + WS_MEMN); bf16_t* kb = (bf16_t*)(ws + WS_KB); bf16_t* vT = (bf16_t*)(ws + WS_VT);
    bf16_t* r1 = (bf16_t*)(ws + WS_R1);
    bf16_t* Hb = (bf16_t*)(ws + WS_HB);
    bf16_t* sg = Hb; bf16_t* pbuf = (bf16_t*)(ws + WS_HB + 128 * MiB);
    bf16_t* qb = Hb; bf16_t* Pb = (bf16_t*)(ws + WS_HB + 64 * MiB);
    bf16_t* pooled = (bf16_t*)(ws + WS_R2); bf16_t* yact = (bf16_t*)(ws + WS_R2 + 32 * MiB); float* states = (float*)(ws + WS_R2 + 48 * MiB); bf16_t* ux = (bf16_t*)(ws + WS_R2 + 56 * MiB);
    bf16_t* r3 = (bf16_t*)(ws + WS_R3);
    float* hout = a.out;

#ifndef PHMASK
#define PHMASK 0xffff
#endif
#define IN(k) (((PHMASK >> (k)) & 1) && a.ph_lo <= (k) && (k) < a.ph_hi)
#define SEAM(k) do { if (IN(k) && IN((k) + 1)) grid.sync(); } while (0)

    if (IN(0)) {
        LAS float* scr = (LAS float*)(lds + wave * 16384);
        constexpr int I_FF = (DM / 64) * (FF / 32), I_FD = (FF / 64) * (DM / 32), I_GL = (DSSM / 64) * (DM / 32), I_SQ = (DM / 64) * (DM / 32), I_KV = (DM / 64) * (2048 / 32);
        constexpr int NITEMS = 4 * I_FF + 2 * I_FD + I_FF + 2 * I_GL + 3 * I_SQ + I_KV;
#define TR(SRC, KK, NN, DST, MODE, GK) { constexpr int items_ = ((KK) / 64) * ((NN) / 32); if (r < items_) { const int nblk = (NN) / 32, kb_ = r / nblk, nb_ = r % nblk, n0 = nb_ * 32; \
            const int orow = (MODE) == 0 ? n0 : (((n0 >> 7) << 8) + (n0 & 127) + ((MODE) == 2 ? 128 : 0)); tr_item(SRC, NN, DST, KK, orow, GK, scr, kb_ * 64, n0, lane); continue; } r -= items_; }
        for (int it = gw; it < NITEMS; it += NGW) {
            int r = it;
            TR(a.in[3], DM, FF, w1gu, 1, a.in[2]) TR(a.in[4], DM, FF, w1gu, 2, a.in[2]) TR(a.in[5], FF, DM, w1d, 0, nullptr)
            TR(a.in[28], DM, FF, w2gu, 1, a.in[27]) TR(a.in[29], DM, FF, w2gu, 2, a.in[27]) TR(a.in[30], FF, DM, w2d, 0, nullptr)
            TR(a.in[7], DM, DIN, win, 0, a.in[6])
            TR(a.in[19], DSSM, DM, wglu, 1, nullptr) TR(a.in[20], DSSM, DM, wglu, 2, nullptr)
            TR(a.in[21], DM, DM, wmo, 0, nullptr) TR(a.in[24], DM, DM, wq, 0, a.in[22]) TR(a.in[26], DM, DM, wxo, 0, nullptr)
            TR(a.in[25], DM, 2048, wkv, 0, nullptr)
        }
#undef TR
        for (int mrow = gw; mrow < MTOK + MEMROWS; mrow += NGW) {
            const bool is_x = mrow < MTOK; const int row = is_x ? mrow : mrow - MTOK;
            const f32x4* xr = (const f32x4*)((is_x ? a.in[0] : a.in[1]) + (size_t)row * DM) + lane;
            f32x4 v[4]; float s = 0.f;
#pragma unroll
            for (int j = 0; j < 4; ++j) { v[j] = xr[64 * j]; s += (v[j].x * v[j].x + v[j].y * v[j].y) + (v[j].z * v[j].z + v[j].w * v[j].w); }
            s = wave_sum(s);
            u32x2* o8 = (u32x2*)((is_x ? r1 : memn) + (size_t)row * DM) + lane;
            if (is_x) {
#pragma unroll
                for (int j = 0; j < 4; ++j) { u32x2 w; w.x = cvt_pk_bf16(v[j].x, v[j].y); w.y = cvt_pk_bf16(v[j].z, v[j].w); o8[64 * j] = w; }
                if (lane < 16) ss0[(size_t)row * 16 + lane] = lane == 0 ? s : 0.f;
            } else {
                const float rs = rsqrtf(s * (1.0f / 1024.0f) + EPS); const f32x4* gr = (const f32x4*)a.in[23] + lane;
#pragma unroll
                for (int j = 0; j < 4; ++j) { const f32x4 gg = gr[64 * j]; u32x2 w; w.x = cvt_pk_bf16(v[j].x * rs * gg.x, v[j].y * rs * gg.y); w.y = cvt_pk_bf16(v[j].z * rs * gg.z, v[j].w * rs * gg.w); o8[64 * j] = w; }
            }
        }
        if (gtid < 2048) {
            const int idx = gtid, dg = idx >> 6;
            const float dt = expf(a.in[13][dg]);
            const float ar = a.in[11][idx], ai = a.in[12][idx];
            const float mag = expf(dt * ar), ang = dt * ai;
            const float abr = mag * cosf(ang), abi = mag * sinf(ang);
            const float den = ar * ar + ai * ai, nr = abr - 1.0f;
            const float qr = (nr * ar + abi * ai) / den, qi = (abi * ar - nr * ai) / den;
            for (int h = 0; h < 16; ++h) { const float br = a.in[14][idx * 16 + h], bi = a.in[15][idx * 16 + h]; bbar[idx * 16 + h] = (f32x2){qr * br - qi * bi, qr * bi + qi * br}; }
            double pr = 1.0, pi = 0.0; const double dr = (double)abr, di = (double)abi;
            for (int t = 0; t <= 64; ++t) { pw[idx * 65 + t] = (f32x2){(float)pr, (float)pi}; const double nr2 = pr * dr - pi * di, ni2 = pr * di + pi * dr; pr = nr2; pi = ni2; }
        }
    }
    SEAM(0);

    if (IN(1)) {
        for (int idx = gtid; idx < 2 * 16 * 64 * 256; idx += NT) {
            const int h2 = idx & 15, h = (idx >> 4) & 15, tau = (idx >> 8) & 63, dg = idx >> 14;
            float s = 0.f;
            for (int p = 0; p < 64; ++p) {
                const float cr = a.in[16][(dg * 16 + h) * 64 + p], ci = a.in[17][(dg * 16 + h) * 64 + p];
                const f32x2 w = pw[(dg * 64 + p) * 65 + tau], b = bbar[(dg * 64 + p) * 16 + h2];
                const float wr_ = w.x * b.x - w.y * b.y, wi_ = w.x * b.y + w.y * b.x;
                s += cr * wr_ - ci * wi_;
            }
            kt[idx] = s;
        }
        for (int idx = gtid; idx < 16 * 256 * 128; idx += NT) {
            const int k8 = idx & 127, j = (idx >> 7) & 255, g = idx >> 15;
            const int s = k8 >> 1, h0 = (k8 & 1) * 8, dd = j >> 7, part = (j >> 6) & 1, p = j & 63, dgp = ((dd * 16 + g) * 64 + p);
            const f32x2 w = pw[dgp * 65 + (dd == 0 ? 63 - s : s)];
            float o[8];
#pragma unroll
            for (int e = 0; e < 8; ++e) { const f32x2 b = bbar[dgp * 16 + h0 + e]; o[e] = part == 0 ? (w.x * b.x - w.y * b.y) : (w.x * b.y + w.y * b.x); }
            u32x4 v; v.x = cvt_pk_bf16(o[0], o[1]); v.y = cvt_pk_bf16(o[2], o[3]); v.z = cvt_pk_bf16(o[4], o[5]); v.w = cvt_pk_bf16(o[6], o[7]);
            *(u32x4*)(sE + ((size_t)(g * 256 + j)) * 1024 + k8 * 8) = v;
        }
        for (int idx = gtid; idx < 16 * 1024 * 32; idx += NT) {
            const int j8 = idx & 31, n = (idx >> 5) & 1023, g = idx >> 15;
            const int j0 = j8 * 8, dd = j0 >> 7, part = (j0 >> 6) & 1, p0 = j0 & 63, t = n >> 4, h = n & 15, tau = dd == 0 ? t + 1 : 64 - t;
            float o[8];
#pragma unroll
            for (int e = 0; e < 8; ++e) {
                const int p = p0 + e; const float cr = a.in[16][((dd * 16 + g) * 16 + h) * 64 + p], ci = a.in[17][((dd * 16 + g) * 16 + h) * 64 + p];
                const f32x2 w = pw[((dd * 16 + g) * 64 + p) * 65 + tau];
                o[e] = part == 0 ? (cr * w.x - ci * w.y) : -(cr * w.y + ci * w.x);
            }
            u32x4 v; v.x = cvt_pk_bf16(o[0], o[1]); v.y = cvt_pk_bf16(o[2], o[3]); v.z = cvt_pk_bf16(o[4], o[5]); v.w = cvt_pk_bf16(o[6], o[7]);
            *(u32x4*)(sY + ((size_t)(g * 1024 + n)) * UXLD + 1024 + j0) = v;
        }
        for (int idx = gtid; idx < 512 * 1024; idx += NT) {
            const int n = idx & 1023, kc = idx >> 10, g = kc >> 7;
            const float* pwr = a.in[8] + (size_t)kc * 128; const float* psc = a.in[9] + g * 128; const float* wp = a.in[10] + (size_t)(g * 128) * DM + n;
            float s = 0.f;
            for (int d = 0; d < 128; ++d) s += pwr[d] * psc[d] * wp[(size_t)d * DM];
            wpe[(size_t)n * DPOOL + kc] = (bf16_t)(cvt_pk_bf16(s, 0.f) & 0xffffu);
        }
        pg8::Gemm g{r1, w1gu, DM, DM, DM, 0, 0}; pg8::StaticOrder S; S.init(MTOK, 2 * FF, G, bx);
        pg8::EpiSwiGLU E{Hb, ss0};
        pg8::gemm_phase<pg8::EpiSwiGLU, pg8::StaticOrder, true>(lds, g, S, E);
    }
    SEAM(1);

    if (IN(2)) {
        for (int idx = gtid; idx < 16 * 1024 * 128; idx += NT) {
            const int k8 = idx & 127, n = (idx >> 7) & 1023, g = idx >> 17;
            const int s = k8 >> 1, h0 = (k8 & 1) * 8, t = n >> 4, h = n & 15;
            float o[8];
#pragma unroll
            for (int e = 0; e < 8; ++e) {
                const int h2 = h0 + e; float v = 0.f;
                if (s <= t) v += kt[((0 * 16 + g) * 64 + (t - s)) * 256 + h * 16 + h2];
                if (s >= t) v += kt[((1 * 16 + g) * 64 + (s - t)) * 256 + h * 16 + h2];
                if (s == t && h == h2) v += a.in[18][g * 16 + h];
                o[e] = v;
            }
            u32x4 v; v.x = cvt_pk_bf16(o[0], o[1]); v.y = cvt_pk_bf16(o[2], o[3]); v.z = cvt_pk_bf16(o[4], o[5]); v.w = cvt_pk_bf16(o[6], o[7]);
            *(u32x4*)(sY + ((size_t)(g * 1024 + n)) * UXLD + k8 * 8) = v;
        }
        pg8::Gemm g{Hb, w1d, FF, FF, FF, 0, 0}; pg8::StaticOrder S; S.init(MTOK, DM, G, bx);
        pg8::EpiResid<true> E{a.in[0], hout, r1, ss1, 0.5f};
        pg8::gemm_phase<pg8::EpiResid<true>, pg8::StaticOrder, true>(lds, g, S, E);
    }
    SEAM(2);

    if (IN(3)) {
        { pg8::Gemm g{r1, win, DM, DM, DM, 0, 0}; pg8::StaticOrder S; S.init(MTOK, DIN, G, bx);
          pg8::EpiWin E{pbuf, ux, sg, ss1};
          pg8::gemm_phase<pg8::EpiWin, pg8::StaticOrder, true>(lds, g, S, E); }
        {
          pg8::Gemm g{memn, wkv, DM, DM, DM, 0, 0}; pg8::StaticOrder S; S.init(MEMROWS, DM, 64, (bx >= 128 && bx < 192) ? bx - 128 : -1);
          pg8::EpiBf16<false> E{kb, DM, 0, 256, 0, nullptr, 1.0f};
          pg8::gemm_phase<pg8::EpiBf16<false>, pg8::StaticOrder, true>(lds, g, S, E); }
        {
          pg8::Gemm g{wkv + (size_t)DM * DM, memn, DM, DM, DM, 0, 0}; pg8::StaticOrder S; S.init(DM, MEMROWS, 64, (bx >= 192) ? bx - 192 : -1);
          pg8::EpiBf16<false> E{vT, 256, 1024, 0, 0, nullptr, 1.0f};
          pg8::gemm_phase<pg8::EpiBf16<false>, pg8::StaticOrder, true>(lds, g, S, E); }
    }
    SEAM(3);

    if (IN(4)) {
        { pg8::Gemm g{ux, sE, UXLD, 1024, 1024, (size_t)NCH * UXLD, (size_t)256 * 1024}; pg8::GenOrder<0> S{32, 2, 1, G, bx};
          pg8::EpiStates E{states};
          pg8::gemm_phase<pg8::EpiStates, pg8::GenOrder<0>, true>(lds, g, S, E); }
        for (int idx = gtid; idx < MTOK * 64; idx += NT) {
            const int c8 = idx & 63, row = idx >> 6, t = row & (SEQL - 1), ch0 = c8 * 8, gi = ch0 >> 7, w = 2 << gi, left = w >> 1, right = w - 1 - left;
            const int lo = max(t - left, 0), hi = min(t + right + 1, SEQL);
            float acc8[8];
#pragma unroll
            for (int e = 0; e < 8; ++e) acc8[e] = 0.f;
            const bf16_t* base = pbuf + (size_t)(row - t) * DPOOL + ch0;
            for (int tt = lo; tt < hi; ++tt) {
                const u32x4 v = *(const u32x4*)(base + (size_t)tt * DPOOL);
                acc8[0] += bf_lo(v.x); acc8[1] += bf_hi(v.x); acc8[2] += bf_lo(v.y); acc8[3] += bf_hi(v.y); acc8[4] += bf_lo(v.z); acc8[5] += bf_hi(v.z); acc8[6] += bf_lo(v.w); acc8[7] += bf_hi(v.w);
            }
            const u32x4 sv = *(const u32x4*)(base + (size_t)t * DPOOL); const float inv = 1.0f / (float)(hi - lo);
            u32x4 o; o.x = cvt_pk_bf16(acc8[0] * inv - bf_lo(sv.x), acc8[1] * inv - bf_hi(sv.x)); o.y = cvt_pk_bf16(acc8[2] * inv - bf_lo(sv.y), acc8[3] * inv - bf_hi(sv.y));
            o.z = cvt_pk_bf16(acc8[4] * inv - bf_lo(sv.z), acc8[5] * inv - bf_hi(sv.z)); o.w = cvt_pk_bf16(acc8[6] * inv - bf_lo(sv.w), acc8[7] * inv - bf_hi(sv.w));
            *(u32x4*)(pooled + (size_t)row * DPOOL + ch0) = o;
        }
    }
    SEAM(4);

    if (IN(5)) {
        if (gtid < 16384) {
            const int p = gtid & 63, dd = (gtid >> 6) & 1, g = (gtid >> 7) & 15, b = gtid >> 11;
            const f32x2 lam = pw[((dd * 16 + g) * 64 + p) * 65 + 64];
            float xr = 0.f, xi = 0.f;
            const size_t jre = dd * 128 + p, jim = jre + 64;
            for (int cc = 0; cc < 64; cc += 8) {
                float sr[8], si[8];
#pragma unroll
                for (int e = 0; e < 8; ++e) { const int c = dd == 0 ? cc + e : 63 - (cc + e); const size_t nrow = (size_t)(g * NCH + b * 64 + c); sr[e] = states[nrow * 256 + jre]; si[e] = states[nrow * 256 + jim]; }
#pragma unroll
                for (int e = 0; e < 8; ++e) { const int c = dd == 0 ? cc + e : 63 - (cc + e); const size_t nrow = (size_t)(g * NCH + b * 64 + c);
                    ux[nrow * UXLD + 1024 + jre] = (bf16_t)(cvt_pk_bf16(xr, 0.f) & 0xffffu); ux[nrow * UXLD + 1024 + jim] = (bf16_t)(cvt_pk_bf16(xi, 0.f) & 0xffffu);
                    const float nr = lam.x * xr - lam.y * xi + sr[e], ni = lam.x * xi + lam.y * xr + si[e]; xr = nr; xi = ni; }
            }
        }
        pg8::Gemm g{pooled, wpe, DPOOL, DPOOL, DPOOL, 0, 0}; pg8::StaticOrder S; S.init(MTOK, DM, G, bx);
        pg8::EpiPool E{r1, sg};
        pg8::gemm_phase<pg8::EpiPool, pg8::StaticOrder, true>(lds, g, S, E);
    }
    SEAM(5);

    if (IN(6)) {
        pg8::Gemm g{ux, sY, UXLD, UXLD, UXLD, (size_t)NCH * UXLD, (size_t)1024 * UXLD}; pg8::GenOrder<0> S{128, 2, 4, G, bx};
        pg8::EpiSsmY E{yact};
        pg8::gemm_phase<pg8::EpiSsmY, pg8::GenOrder<0>, true>(lds, g, S, E);
    }
    SEAM(6);

    if (IN(7)) {
        pg8::Gemm g{yact, wglu, DSSM, DSSM, DSSM, 0, 0}; pg8::StaticOrder S; S.init(MTOK, 2048, G, bx);
        pg8::EpiGLU E{r3, r1, sg};
        pg8::gemm_phase<pg8::EpiGLU, pg8::StaticOrder, true>(lds, g, S, E);
    }
    SEAM(7);

    if (IN(8)) {
        pg8::Gemm g{r3, wmo, DM, DM, DM, 0, 0}; pg8::StaticOrder S; S.init(MTOK, DM, G, bx);
        pg8::EpiResid<true> E{hout, hout, r1, ss2, 1.0f};
        pg8::gemm_phase<pg8::EpiResid<true>, pg8::StaticOrder, true>(lds, g, S, E);
    }
    SEAM(8);

    if (IN(9)) {
        pg8::Gemm g{r1, wq, DM, DM, DM, 0, 0}; pg8::StaticOrder S; S.init(MTOK, DM, G, bx);
        pg8::EpiBf16<true> E{qb, DM, 0, 256, 0, ss2, 0.0625f};
        pg8::gemm_phase<pg8::EpiBf16<true>, pg8::StaticOrder, true>(lds, g, S, E);
    }
    SEAM(9);

    if (IN(10)) {
        pg8::Gemm g{qb, kb, DM, DM, 256, 256, 256}; pg8::GenOrder<1> S{512, 0, 0, G, bx};
        pg8::EpiSoftmax E{Pb};
        for (int i = 0;; ++i) {
            pg8::OneUnit O; O.valid = S.next(i, O.u); if (!O.valid) break;
            pg8::gemm_phase<pg8::EpiSoftmax, pg8::OneUnit, false>(lds, g, O, E);
        }
    }
    SEAM(10);

    if (IN(11)) {
        pg8::Gemm g{Pb, vT, DM, 256, 256, 256, 0}; pg8::GenOrder<2> S{512, 0, 0, G, bx};
        pg8::EpiBf16<false> E{r3, DM, 0, 0, 256, nullptr, 1.0f};
        pg8::gemm_phase<pg8::EpiBf16<false>, pg8::GenOrder<2>, true>(lds, g, S, E);
    }
    SEAM(11);

    if (IN(12)) {
        pg8::Gemm g{r3, wxo, DM, DM, DM, 0, 0}; pg8::StaticOrder S; S.init(MTOK, DM, G, bx);
        pg8::EpiResid<true> E{hout, hout, r1, ss3, 1.0f};
        pg8::gemm_phase<pg8::EpiResid<true>, pg8::StaticOrder, true>(lds, g, S, E);
    }
    SEAM(12);

    if (IN(13)) {
        pg8::Gemm g{r1, w2gu, DM, DM, DM, 0, 0}; pg8::StaticOrder S; S.init(MTOK, 2 * FF, G, bx);
        pg8::EpiSwiGLU E{Hb, ss3};
        pg8::gemm_phase<pg8::EpiSwiGLU, pg8::StaticOrder, true>(lds, g, S, E);
    }
    SEAM(13);

    if (IN(14)) {
        pg8::Gemm g{Hb, w2d, FF, FF, FF, 0, 0}; pg8::StaticOrder S; S.init(MTOK, DM, G, bx);
        pg8::EpiResid<false> E{hout, hout, nullptr, ss4, 0.5f};
        pg8::gemm_phase<pg8::EpiResid<false>, pg8::StaticOrder, true>(lds, g, S, E);
    }
    SEAM(14);

    if (IN(15)) {
        const f32x4* gr = (const f32x4*)a.in[31] + lane;
        f32x4 gg[4];
#pragma unroll
        for (int j = 0; j < 4; ++j) gg[j] = gr[64 * j];
        for (int row = gw; row < MTOK; row += NGW) {
            const float rs = row_rstd(ss4, row);
            f32x4* xr = (f32x4*)(hout + (size_t)row * DM) + lane;
#pragma unroll
            for (int j = 0; j < 4; ++j) { f32x4 v = xr[64 * j]; v = v * rs * gg[j]; xr[64 * j] = v; }
        }
    }
#undef IN
#undef SEAM
}

constexpr int LDS_BYTES = 147456;

extern "C" void kernel_launch(void* const* d_in, const int* in_sizes, int n_in, void* d_out, int out_size, void* d_ws, size_t ws_size, hipStream_t stream) {
    static int grid = 0;
    if (grid == 0) {
        if (n_in != 32 || in_sizes[0] != MTOK * DM || out_size != MTOK * DM || ws_size < WS_END) { fprintf(stderr, "kernel_launch: unexpected shapes (n_in %d, ws %zu)\n", n_in, ws_size); grid = -1; return; }
        int dev = 0, cus = 0, per_cu = 0;
        hipGetDevice(&dev); hipDeviceGetAttribute(&cus, hipDeviceAttributeMultiprocessorCount, dev);
        hipFuncSetAttribute((const void*)mk_fwd, hipFuncAttributeMaxDynamicSharedMemorySize, LDS_BYTES);
        hipOccupancyMaxActiveBlocksPerMultiprocessor(&per_cu, (const void*)mk_fwd, 512, LDS_BYTES);
        if (per_cu < 1) per_cu = 1;
        if (per_cu > 1) per_cu = 1;
        grid = cus * per_cu;
        (void)hipGetLastError();
    }
    if (grid < 0) return;
    Args a{};
    for (int i = 0; i < 32; ++i) a.in[i] = (const float*)d_in[i];
    a.out = (float*)d_out; a.ws = (unsigned char*)d_ws;
#if MK_SINGLE
    a.ph_lo = 0; a.ph_hi = NPHASE;
    void* args[] = {&a};
    hipError_t e = hipLaunchCooperativeKernel((const void*)mk_fwd, dim3(grid), dim3(512), args, LDS_BYTES, stream);
    if (e != hipSuccess) fprintf(stderr, "cooperative launch failed: %s (grid %d)\n", hipGetErrorString(e), grid);
#else
    for (int ph = 0; ph < NPHASE; ++ph) {
        a.ph_lo = ph; a.ph_hi = ph + 1;
        hipLaunchKernelGGL(mk_fwd, dim3(grid), dim3(512), LDS_BYTES, stream, a);
    }
#endif
}
```

```cpp
#include <hip/hip_runtime.h>
#include <hip/hip_cooperative_groups.h>
#include <cstdio>
#include <cstdint>
namespace cg = cooperative_groups;

#ifndef MK_SINGLE
#define MK_SINGLE 1
#endif

#define LAS __attribute__((address_space(3)))
typedef unsigned short bf16_t;
typedef short bf16x8 __attribute__((ext_vector_type(8)));
typedef float f32x4 __attribute__((ext_vector_type(4)));
typedef float f32x2 __attribute__((ext_vector_type(2)));
typedef unsigned u32x4 __attribute__((ext_vector_type(4)));
typedef unsigned u32x2 __attribute__((ext_vector_type(2)));

constexpr int MTOK = 32768, DM = 1024, FF = 2816, DIN = 2816, SEQL = 4096, NB = 8, NMEM = 256, MEMROWS = 2048;
constexpr int DPOOL = 512, DSSM = 256, NG = 16, CH = 64  , NCH = 512  , UXLD = 1280;
constexpr float EPS = 1e-6f;

constexpr size_t MiB = 1u << 20;
constexpr size_t WS_SS = 0;
constexpr size_t WS_PW = 10 * MiB;
constexpr size_t WS_BBAR = 11 * MiB + 256 * 1024;
constexpr size_t WS_KT = 12 * MiB;
constexpr size_t WS_W1GU = 14 * MiB;
constexpr size_t WS_W1D = WS_W1GU + 11 * MiB;
constexpr size_t WS_W2GU = WS_W1D + 5 * MiB + 512 * 1024;
constexpr size_t WS_W2D = WS_W2GU + 11 * MiB;
constexpr size_t WS_WIN = WS_W2D + 5 * MiB + 512 * 1024;
constexpr size_t WS_WPE = WS_WIN + 5 * MiB + 512 * 1024;
constexpr size_t WS_WGLU = WS_WPE + 1 * MiB;
constexpr size_t WS_WMO = WS_WGLU + 1 * MiB;
constexpr size_t WS_WQ = WS_WMO + 2 * MiB;
constexpr size_t WS_WKV = WS_WQ + 2 * MiB;
constexpr size_t WS_WXO = WS_WKV + 4 * MiB;
constexpr size_t WS_SE = WS_WXO + 2 * MiB;
constexpr size_t WS_SY = WS_SE + 8 * MiB;
constexpr size_t WS_MEMN = WS_SY + 40 * MiB;
constexpr size_t WS_KB = WS_MEMN + 4 * MiB;
constexpr size_t WS_VT = WS_KB + 4 * MiB;
constexpr size_t WS_R1 = WS_VT + 4 * MiB;
constexpr size_t WS_HB = WS_R1 + 64 * MiB;
constexpr size_t WS_R2 = WS_HB + 176 * MiB;
constexpr size_t WS_R3 = WS_R2 + 76 * MiB;
constexpr size_t WS_END = WS_R3 + 64 * MiB;
static_assert(WS_END <= 512 * MiB, "workspace map");

__device__ __forceinline__ unsigned cvt_pk_bf16(float lo, float hi) { unsigned r; asm volatile("v_cvt_pk_bf16_f32 %0, %1, %2" : "=v"(r) : "v"(lo), "v"(hi)); return r; }
__device__ __forceinline__ float bf_lo(unsigned w) { return __uint_as_float(w << 16); }
__device__ __forceinline__ float bf_hi(unsigned w) { return __uint_as_float(w & 0xffff0000u); }
__device__ __forceinline__ float wave_sum(float v) {
#pragma unroll
    for (int o = 1; o < 64; o <<= 1) v += __shfl_xor(v, o);
    return v;
}
__device__ __forceinline__ float sigmoid_f(float v) { return __builtin_amdgcn_rcpf(1.0f + __builtin_amdgcn_exp2f(-1.4426950408889634f * v)); }
__device__ __forceinline__ float gelu_tanh_f(float x) { const float z = 1.5957691216057308f * (x + 0.044715f * x * x * x); return x * sigmoid_f(z); }
__device__ __forceinline__ float row_rstd(const float* ss, int row) {
    const f32x4* p = (const f32x4*)(ss + (size_t)row * 16);
    const f32x4 a = p[0], b = p[1], c = p[2], d = p[3];
    const float s = ((a.x + a.y) + (a.z + a.w)) + ((b.x + b.y) + (b.z + b.w)) + ((c.x + c.y) + (c.z + c.w)) + ((d.x + d.y) + (d.z + d.w));
    return rsqrtf(s * (1.0f / 1024.0f) + EPS);
}
#define LDS_WAIT() asm volatile("s_waitcnt lgkmcnt(0)" ::: "memory")

namespace pg8 {
constexpr int BM = 256, BK = 64, HALF = 128, HTB = HALF * BK * 2, STAGE_BYTES = 8 * HTB, NXCD = 8, WGM = 8;
__host__ __device__ __forceinline__ int lds_byte(int r, int c) { const int st = (r >> 4) * 2 + (c >> 5), rr = r & 15, cc = c & 31, ob = rr * 64 + cc * 2; return st * 1024 + (ob ^ (((ob >> 9) & 1) << 5)); }
__host__ __device__ __forceinline__ void stage_rc(int b, int& R, int& C) { const int st = b / 1024, sb = b % 1024, swz = sb ^ (((sb >> 9) & 1) << 5); R = (st >> 1) * 16 + swz / 64; C = (st & 1) * 32 + (swz % 64) / 2; }
__host__ __device__ __forceinline__ int perm32(int rho) { const int n = rho >> 4, i = rho & 15; return 8 * (i >> 2) + 4 * n + (i & 3); }

struct Unit { int pm, pn, za, zb; };
struct Gemm { const bf16_t* A; const bf16_t* Bt; int lda, ldb, K; size_t sAz, sBz; };

struct StaticOrder {
    int nM, nN, nwg, G, c, off, imax;
    __device__ void init(int M, int N, int G_, int c_, int off_ = 0, int imax_ = 1 << 30) { nM = M / BM; nN = N / BM; nwg = nM * nN; G = G_; c = c_; off = off_; imax = imax_; }
    __device__ bool next(int i, Unit& u) const {
        if (c < 0 || i >= imax) return false;
        const long L = (long)off + (long)i * G + c; if (L >= nwg) return false;
        int wgid = (int)L; { const int q = nwg / NXCD, r = nwg % NXCD, xcd = wgid % NXCD, off = wgid / NXCD; wgid = (xcd < r ? xcd * (q + 1) : r * (q + 1) + (xcd - r) * q) + off; }
        const int nig = WGM * nN, gid = wgid / nig, fm = gid * WGM, gsz = (nM - fm) < WGM ? (nM - fm) : WGM;
        u.pm = fm + ((wgid % nig) % gsz); u.pn = (wgid % nig) / gsz; u.za = 0; u.zb = 0; return true;
    }
};
template <int KIND> struct GenOrder {
    int n, nM, nN, G, c;
    __device__ bool next(int i, Unit& u) const {
        if (c < 0) return false;
        const int L = i * G + c; if (L >= n) return false;
        if (KIND == 0) { const int per = nM * nN, z = L / per, rem = L % per; u.pm = rem % nM; u.pn = rem / nM; u.za = z; u.zb = z; }
        else if (KIND == 1) { const int h = L & 3, pm = L >> 2; u.pm = pm; u.pn = pm >> 4; u.za = h; u.zb = h; }
        else { const int h = L & 3, pm = L >> 2; u.pm = pm; u.pn = (pm >> 4) * 4 + h; u.za = h; u.zb = 0; }
        return true;
    }
};
struct OneUnit { Unit u; bool valid; __device__ bool next(int i, Unit& o) const { if (i != 0 || !valid) return false; o = u; return true; } };

__device__ __forceinline__ const char* aptr(const Gemm& g, const Unit& u) { return (const char*)g.A + ((size_t)u.pm * BM * g.lda + (size_t)u.za * g.sAz) * 2; }
__device__ __forceinline__ const char* bptr(const Gemm& g, const Unit& u) { return (const char*)g.Bt + ((size_t)u.pn * BM * g.ldb + (size_t)u.zb * g.sBz) * 2; }

template <class Epi, class Sched, bool ALIGN_EPI>
__device__ __forceinline__ void gemm_phase(LAS unsigned char* lds, const Gemm g, const Sched& S, const Epi& E) {
    const int tid = threadIdx.x, wid = __builtin_amdgcn_readfirstlane(tid >> 6), lane = tid & 63, wr = wid >> 2, wc = wid & 3, fr = lane & 15, fq = lane >> 4;
    const int K = g.K, nt = K / BK;
    unsigned voffA[2], voffB[2];
#pragma unroll
    for (int i = 0; i < 2; ++i) { int R, C; stage_rc(tid * 16 + i * 8192, R, C); const int Rb = Epi::PERM ? ((R & ~31) + perm32(R & 31)) : R;
        voffA[i] = (unsigned)(R * g.lda + C) * 2u; voffB[i] = (unsigned)(Rb * g.ldb + C) * 2u; }
    const size_t kstep = (size_t)(BK * 2);
    const size_t hstepA = (size_t)HALF * g.lda * 2, hstepB = (size_t)HALF * g.ldb * 2;
    const unsigned ldsw = (unsigned)wid * 1024u;
    const int aoff = lds_byte(wr * 64 + fr, fq * 8), boff = lds_byte(wc * 32 + fr, fq * 8);
#define PG8_SA(b, h) (((b) * 2 + (h)) * HTB)
#define PG8_SB(b, h) ((4 + (b) * 2 + (h)) * HTB)
#define PG8_STAGE(bufoff, gbase, voff) do { _Pragma("unroll") for (int _i = 0; _i < 2; ++_i) \
        __builtin_amdgcn_global_load_lds((const unsigned*)((const char*)(gbase) + (voff)[_i]), (LAS unsigned*)(lds + (bufoff) + ldsw + _i * 8192), 16, 0, 0); } while (0)
#define PG8_LDA(dst, b, h) do { _Pragma("unroll") for (int m = 0; m < 4; ++m) _Pragma("unroll") for (int k = 0; k < 2; ++k) dst[m][k] = *(const LAS bf16x8*)(lds + PG8_SA(b, h) + aoff + m * 2048 + k * 1024); } while (0)
#define PG8_LDB(dst, b, h) do { _Pragma("unroll") for (int n = 0; n < 2; ++n) _Pragma("unroll") for (int k = 0; k < 2; ++k) dst[n][k] = *(const LAS bf16x8*)(lds + PG8_SB(b, h) + boff + n * 2048 + k * 1024); } while (0)
#define PG8_MMA(ai, bj, At, Bt) do { __builtin_amdgcn_s_setprio(1); _Pragma("unroll") for (int m = 0; m < 4; ++m) _Pragma("unroll") for (int n = 0; n < 2; ++n) _Pragma("unroll") for (int k = 0; k < 2; ++k) \
        acc[ai][bj][m][n] = __builtin_amdgcn_mfma_f32_16x16x32_bf16(Bt[n][k], At[m][k], acc[ai][bj][m][n], 0, 0, 0); __builtin_amdgcn_s_setprio(0); } while (0)
#define PG8_WAIT_V(n) asm volatile("s_waitcnt vmcnt(" #n ")" ::: "memory")
#define PG8_WAIT_L(n) asm volatile("s_waitcnt lgkmcnt(" #n ")" ::: "memory")
#define PG8_BAR __builtin_amdgcn_s_barrier()
#define PG8_SCHED __builtin_amdgcn_sched_barrier(0)
    Unit cur, nxt; int ui = 0;
    if (!S.next(0, cur)) return;
    f32x4 acc[2][2][4][2];
#pragma unroll
    for (int a = 0; a < 2; ++a)
#pragma unroll
        for (int b = 0; b < 2; ++b)
#pragma unroll
            for (int m = 0; m < 4; ++m)
#pragma unroll
                for (int n = 0; n < 2; ++n) acc[a][b][m][n] = (f32x4){0.f, 0.f, 0.f, 0.f};
    bf16x8 At[4][2], B0[2][2], B1[2][2];
    const char* cA = aptr(g, cur); const char* cB = bptr(g, cur);
    PG8_STAGE(PG8_SB(0, 0), cB, voffB); PG8_STAGE(PG8_SB(0, 1), cB + hstepB, voffB); PG8_STAGE(PG8_SA(0, 0), cA, voffA); PG8_STAGE(PG8_SA(0, 1), cA + hstepA, voffA);
    if (wr == 1) PG8_BAR;
    PG8_WAIT_V(2); PG8_BAR;
    PG8_STAGE(PG8_SB(1, 0), cB + kstep, voffB); PG8_STAGE(PG8_SA(1, 0), cA + kstep, voffA); PG8_STAGE(PG8_SB(1, 1), cB + hstepB + kstep, voffB);
    PG8_WAIT_V(6); PG8_BAR;
    for (;;) {
        const bool has_next = S.next(ui + 1, nxt);
        const char* nA = has_next ? aptr(g, nxt) : cA; const char* nB = has_next ? bptr(g, nxt) : cB;
#pragma nounroll
        for (int t = 0; t < nt; t += 2) {
            const bool last = (t == nt - 2);
            const char* a1 = cA + (size_t)(t + 1) * kstep;
            const char* a2 = last ? nA : cA + (size_t)(t + 2) * kstep; const char* b2 = last ? nB : cB + (size_t)(t + 2) * kstep;
            const char* a3 = a2 + kstep; const char* b3 = b2 + kstep;
            PG8_LDB(B0, 0, 0); PG8_LDB(B1, 0, 1); PG8_SCHED; PG8_LDA(At, 0, 0); PG8_STAGE(PG8_SA(1, 1), a1 + hstepA, voffA);
            PG8_WAIT_V(8); PG8_WAIT_L(0); PG8_BAR; PG8_MMA(0, 0, At, B0); PG8_MMA(0, 1, At, B1); PG8_BAR; PG8_SCHED;
            PG8_LDA(At, 0, 1); PG8_STAGE(PG8_SB(0, 0), b2, voffB); PG8_STAGE(PG8_SB(0, 1), b2 + hstepB, voffB); PG8_STAGE(PG8_SA(0, 0), a2, voffA);
            PG8_WAIT_V(8); PG8_WAIT_L(0); PG8_BAR; PG8_MMA(1, 0, At, B0); PG8_MMA(1, 1, At, B1); PG8_BAR; PG8_SCHED;
            PG8_LDB(B0, 1, 0); PG8_LDB(B1, 1, 1); PG8_SCHED; PG8_LDA(At, 1, 0); PG8_STAGE(PG8_SA(0, 1), a2 + hstepA, voffA);
            PG8_WAIT_V(8); PG8_WAIT_L(0); PG8_BAR; PG8_MMA(0, 0, At, B0); PG8_MMA(0, 1, At, B1); PG8_BAR; PG8_SCHED;
            PG8_LDA(At, 1, 1); PG8_STAGE(PG8_SB(1, 0), b3, voffB); PG8_STAGE(PG8_SB(1, 1), b3 + hstepB, voffB); PG8_STAGE(PG8_SA(1, 0), a3, voffA);
            PG8_WAIT_V(8); PG8_WAIT_L(0); PG8_BAR; PG8_MMA(1, 0, At, B0); PG8_MMA(1, 1, At, B1); PG8_BAR; PG8_SCHED;
        }
        if constexpr (ALIGN_EPI) { if (wr == 0) PG8_BAR; }
        if constexpr (!Epi::AFTER_DRAIN) { E(acc, cur, wr, wc, fr, fq); }
        if (!has_next) break;
#pragma unroll
        for (int a = 0; a < 2; ++a)
#pragma unroll
            for (int b = 0; b < 2; ++b)
#pragma unroll
                for (int m = 0; m < 4; ++m)
#pragma unroll
                    for (int n = 0; n < 2; ++n) acc[a][b][m][n] = (f32x4){0.f, 0.f, 0.f, 0.f};
        cur = nxt; cA = nA; cB = nB; ++ui;
        if constexpr (ALIGN_EPI) { if (wr == 1) PG8_BAR; }
    }
    PG8_WAIT_V(0);
    if constexpr (!ALIGN_EPI) { if (wr == 0) PG8_BAR; }
    PG8_BAR;
    if constexpr (Epi::AFTER_DRAIN) { E.fused(acc, cur, wr, wc, fr, fq, lds, wid, lane); }
#undef PG8_SA
#undef PG8_SB
#undef PG8_STAGE
#undef PG8_LDA
#undef PG8_LDB
#undef PG8_MMA
#undef PG8_WAIT_V
#undef PG8_WAIT_L
#undef PG8_BAR
#undef PG8_SCHED
}

typedef const f32x4 (&AccRef)[2][2][4][2];

struct EpiSwiGLU {
    static constexpr bool PERM = true, AFTER_DRAIN = false;
    bf16_t* H; const float* ss;
    __device__ __forceinline__ void operator()(AccRef acc, const Unit& u, int wr, int wc, int fr, int fq) const {
        const int row0 = u.pm * BM + wr * 64 + fr, col = u.pn * 128 + wc * 32 + 8 * fq;
#pragma unroll
        for (int ai = 0; ai < 2; ++ai)
#pragma unroll
            for (int m = 0; m < 4; ++m) {
                const int row = row0 + ai * HALF + m * 16; const float r = row_rstd(ss, row);
                float o[8];
#pragma unroll
                for (int n = 0; n < 2; ++n)
#pragma unroll
                    for (int j = 0; j < 4; ++j) { const float gv = acc[ai][0][m][n][j] * r, uv = acc[ai][1][m][n][j] * r; o[n * 4 + j] = gv * sigmoid_f(gv) * uv; }
                u32x4 w; w.x = cvt_pk_bf16(o[0], o[1]); w.y = cvt_pk_bf16(o[2], o[3]); w.z = cvt_pk_bf16(o[4], o[5]); w.w = cvt_pk_bf16(o[6], o[7]);
                *(u32x4*)(H + (size_t)row * FF + col) = w;
                asm volatile("" ::: "memory");
            }
    }
};
template <bool WRITE_HB> struct EpiResid {
    static constexpr bool PERM = true, AFTER_DRAIN = false;
    const float* src; float* dst; bf16_t* hb; float* ss; float alpha;
    __device__ __forceinline__ void operator()(AccRef acc, const Unit& u, int wr, int wc, int fr, int fq) const {
        const int row0 = u.pm * BM + wr * 64 + fr, col0 = u.pn * BM + wc * 32 + 8 * fq;
#pragma unroll
        for (int ai = 0; ai < 2; ++ai)
#pragma unroll
            for (int m = 0; m < 4; ++m) {
                const int row = row0 + ai * HALF + m * 16; float q = 0.f;
#pragma unroll
                for (int bj = 0; bj < 2; ++bj) {
                    const size_t off = (size_t)row * DM + col0 + bj * HALF;
                    const f32x4 b0 = *(const f32x4*)(src + off), b1 = *(const f32x4*)(src + off + 4);
                    const f32x4 v0 = b0 + acc[ai][bj][m][0] * alpha, v1 = b1 + acc[ai][bj][m][1] * alpha;
                    *(f32x4*)(dst + off) = v0; *(f32x4*)(dst + off + 4) = v1;
                    q += (v0[0] * v0[0] + v0[1] * v0[1]) + (v0[2] * v0[2] + v0[3] * v0[3]) + (v1[0] * v1[0] + v1[1] * v1[1]) + (v1[2] * v1[2] + v1[3] * v1[3]);
                    if (WRITE_HB) { u32x4 w; w.x = cvt_pk_bf16(v0[0], v0[1]); w.y = cvt_pk_bf16(v0[2], v0[3]); w.z = cvt_pk_bf16(v1[0], v1[1]); w.w = cvt_pk_bf16(v1[2], v1[3]); *(u32x4*)(hb + off) = w; }
                }
                q += __shfl_xor(q, 16); q += __shfl_xor(q, 32);
                if (fq == 0) ss[(size_t)row * 16 + u.pn * 4 + wc] = q;
                asm volatile("" ::: "memory");
            }
    }
};
struct EpiWin {
    static constexpr bool PERM = true, AFTER_DRAIN = false;
    bf16_t* p; bf16_t* ux; bf16_t* sg; const float* ss;
    __device__ __forceinline__ void operator()(AccRef acc, const Unit& u, int wr, int wc, int fr, int fq) const {
        const int row0 = u.pm * BM + wr * 64 + fr, tc0 = wc * 32 + 8 * fq;
#pragma unroll
        for (int ai = 0; ai < 2; ++ai)
#pragma unroll
            for (int m = 0; m < 4; ++m) {
                const int row = row0 + ai * HALF + m * 16; const float r = row_rstd(ss, row);
#pragma unroll
                for (int bj = 0; bj < 2; ++bj) {
                    const int tc = tc0 + bj * HALF;
                    f32x4 v0 = acc[ai][bj][m][0] * r, v1 = acc[ai][bj][m][1] * r;
                    bf16_t* dst;
                    if (u.pn < 2) dst = p + (size_t)row * DPOOL + u.pn * BM + tc;
                    else if (u.pn == 2) { const int gi = tc >> 4, h0 = tc & 15; dst = ux + ((size_t)(gi * NCH + (row >> 6))) * UXLD + (row & 63) * 16 + h0; }
                    else {
                        dst = sg + (size_t)row * 2048 + (u.pn - 3) * BM + tc;
#pragma unroll
                        for (int j = 0; j < 4; ++j) { v0[j] = sigmoid_f(v0[j]); v1[j] = sigmoid_f(v1[j]); }
                    }
                    u32x4 w; w.x = cvt_pk_bf16(v0[0], v0[1]); w.y = cvt_pk_bf16(v0[2], v0[3]); w.z = cvt_pk_bf16(v1[0], v1[1]); w.w = cvt_pk_bf16(v1[2], v1[3]);
                    *(u32x4*)dst = w;
                }
                asm volatile("" ::: "memory");
            }
    }
};
struct EpiPool {
    static constexpr bool PERM = true, AFTER_DRAIN = false;
    bf16_t* zp; const bf16_t* sg;
    __device__ __forceinline__ void operator()(AccRef acc, const Unit& u, int wr, int wc, int fr, int fq) const {
        const int row0 = u.pm * BM + wr * 64 + fr, col0 = u.pn * BM + wc * 32 + 8 * fq;
#pragma unroll
        for (int ai = 0; ai < 2; ++ai)
#pragma unroll
            for (int m = 0; m < 4; ++m) {
                const int row = row0 + ai * HALF + m * 16;
#pragma unroll
                for (int bj = 0; bj < 2; ++bj) {
                    const int col = col0 + bj * HALF;
                    const u32x4 s = *(const u32x4*)(sg + (size_t)row * 2048 + col);
                    const f32x4 a0 = acc[ai][bj][m][0], a1 = acc[ai][bj][m][1];
                    u32x4 w; w.x = cvt_pk_bf16(a0[0] * bf_lo(s.x), a0[1] * bf_hi(s.x)); w.y = cvt_pk_bf16(a0[2] * bf_lo(s.y), a0[3] * bf_hi(s.y));
                    w.z = cvt_pk_bf16(a1[0] * bf_lo(s.z), a1[1] * bf_hi(s.z)); w.w = cvt_pk_bf16(a1[2] * bf_lo(s.w), a1[3] * bf_hi(s.w));
                    *(u32x4*)(zp + (size_t)row * DM + col) = w;
                }
                asm volatile("" ::: "memory");
            }
    }
};
struct EpiGLU {
    static constexpr bool PERM = true, AFTER_DRAIN = false;
    bf16_t* merged; const bf16_t* zp; const bf16_t* sg;
    __device__ __forceinline__ void operator()(AccRef acc, const Unit& u, int wr, int wc, int fr, int fq) const {
        const int row0 = u.pm * BM + wr * 64 + fr, col = u.pn * 128 + wc * 32 + 8 * fq;
#pragma unroll
        for (int ai = 0; ai < 2; ++ai)
#pragma unroll
            for (int m = 0; m < 4; ++m) {
                const int row = row0 + ai * HALF + m * 16;
                const u32x4 z = *(const u32x4*)(zp + (size_t)row * DM + col);
                const u32x4 s = *(const u32x4*)(sg + (size_t)row * 2048 + 1024 + col);
                float o[8];
#pragma unroll
                for (int n = 0; n < 2; ++n)
#pragma unroll
                    for (int j = 0; j < 4; ++j) o[n * 4 + j] = acc[ai][0][m][n][j] * sigmoid_f(acc[ai][1][m][n][j]);
                u32x4 w;
                w.x = cvt_pk_bf16(bf_lo(z.x) + bf_lo(s.x) * o[0], bf_hi(z.x) + bf_hi(s.x) * o[1]);
                w.y = cvt_pk_bf16(bf_lo(z.y) + bf_lo(s.y) * o[2], bf_hi(z.y) + bf_hi(s.y) * o[3]);
                w.z = cvt_pk_bf16(bf_lo(z.z) + bf_lo(s.z) * o[4], bf_hi(z.z) + bf_hi(s.z) * o[5]);
                w.w = cvt_pk_bf16(bf_lo(z.w) + bf_lo(s.w) * o[6], bf_hi(z.w) + bf_hi(s.w) * o[7]);
                *(u32x4*)(merged + (size_t)row * DM + col) = w;
                asm volatile("" ::: "memory");
            }
    }
};
template <bool HAS_SS> struct EpiBf16 {
    static constexpr bool PERM = true, AFTER_DRAIN = false;
    bf16_t* out; int ld, rowpn, colpn, colza; const float* ss; float scale;
    __device__ __forceinline__ void operator()(AccRef acc, const Unit& u, int wr, int wc, int fr, int fq) const {
        const int row0 = u.pm * BM + wr * 64 + fr + u.pn * rowpn, col0 = u.pn * colpn + u.za * colza + wc * 32 + 8 * fq;
        bf16_t* ob = out + (size_t)row0 * ld + col0;
#pragma unroll
        for (int ai = 0; ai < 2; ++ai)
#pragma unroll
            for (int m = 0; m < 4; ++m) {
                float r = scale;
                if (HAS_SS) r *= row_rstd(ss, u.pm * BM + wr * 64 + fr + ai * HALF + m * 16);
#pragma unroll
                for (int bj = 0; bj < 2; ++bj) {
                    const f32x4 v0 = acc[ai][bj][m][0] * r, v1 = acc[ai][bj][m][1] * r;
                    u32x4 w; w.x = cvt_pk_bf16(v0[0], v0[1]); w.y = cvt_pk_bf16(v0[2], v0[3]); w.z = cvt_pk_bf16(v1[0], v1[1]); w.w = cvt_pk_bf16(v1[2], v1[3]);
                    *(u32x4*)(ob + (size_t)(ai * HALF + m * 16) * ld + bj * HALF) = w;
                }
                if (m & 1) asm volatile("" ::: "memory");
            }
    }
};
struct EpiStatesScan {
    static constexpr bool PERM = false, AFTER_DRAIN = true;
    bf16_t* ux; const f32x2* pw;
    __device__ __forceinline__ void fused(f32x4 (&acc)[2][2][4][2], const Unit& u, int wr, int wc, int fr, int fq, LAS unsigned char* lds, int wid, int lane) const {
        LAS float* T = (LAS float*)lds;
        const int tid = threadIdx.x;
#pragma unroll
        for (int half = 0; half < 2; ++half) {
#pragma unroll
            for (int ai = 0; ai < 2; ++ai)
#pragma unroll
                for (int m = 0; m < 4; ++m)
#pragma unroll
                    for (int n = 0; n < 2; ++n) *(LAS f32x4*)(T + (ai * HALF + wr * 64 + m * 16 + fr) * 132 + wc * 32 + n * 16 + 4 * fq) = acc[ai][half][m][n];
            __syncthreads();
            if (tid < 256) {
                const int b = tid >> 6, p = tid & 63;
                const f32x2 lam = pw[((half * 16 + u.za) * 64 + p) * 65 + 64];
                float xr = 0.f, xi = 0.f;
                bf16_t* ob = ux + ((size_t)(u.za * NCH + u.pm * BM + b * 64)) * UXLD + 1024 + half * 128 + p;
#pragma unroll 2
                for (int cc = 0; cc < 64; ++cc) {
                    const int c = half == 0 ? cc : 63 - cc;
                    const float sr = T[(b * 64 + c) * 132 + p], si = T[(b * 64 + c) * 132 + 64 + p];
                    ob[(size_t)c * UXLD] = (bf16_t)(cvt_pk_bf16(xr, 0.f) & 0xffffu); ob[(size_t)c * UXLD + 64] = (bf16_t)(cvt_pk_bf16(xi, 0.f) & 0xffffu);
                    const float nr = lam.x * xr - lam.y * xi + sr, ni = lam.x * xi + lam.y * xr + si; xr = nr; xi = ni;
                }
            }
            __syncthreads();
        }
    }
};
struct EpiSsmY {
    static constexpr bool PERM = true, AFTER_DRAIN = false;
    bf16_t* yact;
    __device__ __forceinline__ void operator()(AccRef acc, const Unit& u, int wr, int wc, int fr, int fq) const {
        const int row0 = u.pm * BM + wr * 64 + fr, c0 = u.pn * BM + wc * 32 + 8 * fq;
#pragma unroll
        for (int ai = 0; ai < 2; ++ai)
#pragma unroll
            for (int m = 0; m < 4; ++m) {
                const int row = row0 + ai * HALF + m * 16;
#pragma unroll
                for (int bj = 0; bj < 2; ++bj) {
                    const int c = c0 + bj * HALF, t = c >> 4, h0 = c & 15;
                    const f32x4 a0 = acc[ai][bj][m][0], a1 = acc[ai][bj][m][1];
                    u32x4 w; w.x = cvt_pk_bf16(gelu_tanh_f(a0[0]), gelu_tanh_f(a0[1])); w.y = cvt_pk_bf16(gelu_tanh_f(a0[2]), gelu_tanh_f(a0[3]));
                    w.z = cvt_pk_bf16(gelu_tanh_f(a1[0]), gelu_tanh_f(a1[1])); w.w = cvt_pk_bf16(gelu_tanh_f(a1[2]), gelu_tanh_f(a1[3]));
                    *(u32x4*)(yact + ((size_t)row * CH + t) * DSSM + u.za * 16 + h0) = w;
                }
                asm volatile("" ::: "memory");
            }
    }
};
struct EpiSoftmax {
    static constexpr bool PERM = true, AFTER_DRAIN = true;
    bf16_t* P;
    __device__ __forceinline__ void fused(f32x4 (&acc)[2][2][4][2], const Unit& u, int wr, int wc, int fr, int fq, LAS unsigned char* lds, int wid, int lane) const {
        LAS float* red = (LAS float*)lds; LAS float* red2 = (LAS float*)(lds + 4096);
#pragma unroll
        for (int ai = 0; ai < 2; ++ai)
#pragma unroll
            for (int m = 0; m < 4; ++m) {
                float mx = -3.0e38f;
#pragma unroll
                for (int bj = 0; bj < 2; ++bj)
#pragma unroll
                    for (int n = 0; n < 2; ++n)
#pragma unroll
                        for (int j = 0; j < 4; ++j) mx = fmaxf(mx, acc[ai][bj][m][n][j]);
                mx = fmaxf(mx, __shfl_xor(mx, 16)); mx = fmaxf(mx, __shfl_xor(mx, 32));
                if (fq == 0) red[(ai * HALF + wr * 64 + m * 16 + fr) * 4 + wc] = mx;
            }
        __syncthreads();
#pragma unroll
        for (int ai = 0; ai < 2; ++ai)
#pragma unroll
            for (int m = 0; m < 4; ++m) {
                const int r = ai * HALF + wr * 64 + m * 16 + fr;
                const f32x4 q = *(const LAS f32x4*)(red + r * 4);
                const float mx = fmaxf(fmaxf(q[0], q[1]), fmaxf(q[2], q[3])) * 1.4426950408889634f; float s = 0.f;
#pragma unroll
                for (int bj = 0; bj < 2; ++bj)
#pragma unroll
                    for (int n = 0; n < 2; ++n)
#pragma unroll
                        for (int j = 0; j < 4; ++j) { const float e = __builtin_amdgcn_exp2f(acc[ai][bj][m][n][j] * 1.4426950408889634f - mx); acc[ai][bj][m][n][j] = e; s += e; }
                s += __shfl_xor(s, 16); s += __shfl_xor(s, 32);
                if (fq == 0) red2[r * 4 + wc] = s;
            }
        __syncthreads();
#pragma unroll
        for (int ai = 0; ai < 2; ++ai)
#pragma unroll
            for (int m = 0; m < 4; ++m) {
                const int r = ai * HALF + wr * 64 + m * 16 + fr;
                const f32x4 q = *(const LAS f32x4*)(red2 + r * 4);
                const float inv = 1.0f / ((q[0] + q[1]) + (q[2] + q[3]));
#pragma unroll
                for (int bj = 0; bj < 2; ++bj) {
                    const f32x4 v0 = acc[ai][bj][m][0] * inv, v1 = acc[ai][bj][m][1] * inv;
                    u32x4 w; w.x = cvt_pk_bf16(v0[0], v0[1]); w.y = cvt_pk_bf16(v0[2], v0[3]); w.z = cvt_pk_bf16(v1[0], v1[1]); w.w = cvt_pk_bf16(v1[2], v1[3]);
                    *(u32x4*)(P + (size_t)(u.pm * BM + r) * DM + u.za * 256 + bj * HALF + wc * 32 + 8 * fq) = w;
                }
            }
        __syncthreads();
    }
};
}

struct TrDesc { const float* W; bf16_t* WT; const float* gk; int N, ldo, orow, k0, n0; };
__device__ __forceinline__ void tr_load(const TrDesc& d, f32x4 (&v)[8], int lane) {
    const int kr = lane >> 3, n4 = (lane & 7) * 4;
#pragma unroll
    for (int i = 0; i < 8; ++i) v[i] = *(const f32x4*)(d.W + (size_t)(d.k0 + i * 8 + kr) * d.N + d.n0 + n4);
    if (d.gk) {
#pragma unroll
        for (int i = 0; i < 8; ++i) v[i] = v[i] * d.gk[d.k0 + i * 8 + kr];
    }
}
__device__ __forceinline__ void tr_store(const TrDesc& d, const f32x4 (&v)[8], LAS float* scr, int lane) {
    const int kr = lane >> 3, n4 = (lane & 7) * 4;
#pragma unroll
    for (int i = 0; i < 8; ++i) { LAS float* q = scr + (i * 8 + kr) * 33 + n4; q[0] = v[i].x; q[1] = v[i].y; q[2] = v[i].z; q[3] = v[i].w; }
    LDS_WAIT();
    const int c = lane & 7;
#pragma unroll
    for (int j = 0; j < 4; ++j) { const int n = (lane >> 3) + 8 * j; const LAS float* t = scr + (8 * c) * 33 + n;
        u32x4 o; o.x = cvt_pk_bf16(t[0 * 33], t[1 * 33]); o.y = cvt_pk_bf16(t[2 * 33], t[3 * 33]); o.z = cvt_pk_bf16(t[4 * 33], t[5 * 33]); o.w = cvt_pk_bf16(t[6 * 33], t[7 * 33]);
        *(u32x4*)(d.WT + (size_t)(d.orow + n) * d.ldo + d.k0 + 8 * c) = o; }
    LDS_WAIT();
}
__device__ __forceinline__ u32x4 opq(u32x4 v) { asm volatile("" : "+v"(v)); return v; }
template <int GI> __device__ __forceinline__ void pool_strip(const bf16_t* pbuf, bf16_t* pooled, int row0, int t0, int ch0) {
    constexpr int W = 2 << GI, LEFT = W / 2, RIGHT = W - 1 - LEFT, NR = 16 + W - 1;
    u32x4 rows[NR];
    const bf16_t* base = pbuf + (size_t)row0 * DPOOL + ch0;
#pragma unroll
    for (int r = 0; r < NR; ++r) { const int t = t0 + r - LEFT; rows[r] = (t >= 0 && t < SEQL) ? *(const u32x4*)(base + (ptrdiff_t)(r - LEFT) * DPOOL) : (u32x4){0u, 0u, 0u, 0u}; }
    float S[8];
#pragma unroll
    for (int e = 0; e < 8; ++e) S[e] = 0.f;
#pragma unroll
    for (int r = 0; r < W; ++r) { const u32x4 v = opq(rows[r]); S[0] += bf_lo(v.x); S[1] += bf_hi(v.x); S[2] += bf_lo(v.y); S[3] += bf_hi(v.y); S[4] += bf_lo(v.z); S[5] += bf_hi(v.z); S[6] += bf_lo(v.w); S[7] += bf_hi(v.w); }
#pragma unroll
    for (int i = 0; i < 16; ++i) {
        const int t = t0 + i; const int lo = max(t - LEFT, 0), hi = min(t + RIGHT + 1, SEQL); const float inv = 1.0f / (float)(hi - lo);
        const u32x4 sv = opq(rows[i + LEFT]);
        u32x4 o; o.x = cvt_pk_bf16(S[0] * inv - bf_lo(sv.x), S[1] * inv - bf_hi(sv.x)); o.y = cvt_pk_bf16(S[2] * inv - bf_lo(sv.y), S[3] * inv - bf_hi(sv.y));
        o.z = cvt_pk_bf16(S[4] * inv - bf_lo(sv.z), S[5] * inv - bf_hi(sv.z)); o.w = cvt_pk_bf16(S[6] * inv - bf_lo(sv.w), S[7] * inv - bf_hi(sv.w));
        *(u32x4*)(pooled + (size_t)(row0 + i) * DPOOL + ch0) = o;
        if (i < 15) { const u32x4 a = opq(rows[i + W]), b = opq(rows[i]);
            S[0] += bf_lo(a.x) - bf_lo(b.x); S[1] += bf_hi(a.x) - bf_hi(b.x); S[2] += bf_lo(a.y) - bf_lo(b.y); S[3] += bf_hi(a.y) - bf_hi(b.y);
            S[4] += bf_lo(a.z) - bf_lo(b.z); S[5] += bf_hi(a.z) - bf_hi(b.z); S[6] += bf_lo(a.w) - bf_lo(b.w); S[7] += bf_hi(a.w) - bf_hi(b.w); }
    }
}

struct Args { const float* in[32]; float* out; unsigned char* ws; int ph_lo, ph_hi; };
constexpr int NPHASE = 16;

__global__ void __launch_bounds__(512, 2) mk_fwd(Args a) {
    extern __shared__ __attribute__((aligned(16))) unsigned char lds_raw[];
    LAS unsigned char* lds = (LAS unsigned char*)lds_raw;
    cg::grid_group grid = cg::this_grid();
    const int tid = threadIdx.x, lane = tid & 63, wave = __builtin_amdgcn_readfirstlane(tid >> 6);
    const int G = gridDim.x, bx = blockIdx.x;
    const int gtid = bx * 512 + tid, NT = G * 512, gw = bx * 8 + wave, NGW = G * 8;
    unsigned char* ws = a.ws;
    float* ss0 = (float*)(ws + WS_SS); float* ss1 = ss0 + (size_t)MTOK * 16; float* ss2 = ss1 + (size_t)MTOK * 16; float* ss3 = ss2 + (size_t)MTOK * 16; float* ss4 = ss3 + (size_t)MTOK * 16;
    f32x2* pw = (f32x2*)(ws + WS_PW); f32x2* bbar = (f32x2*)(ws + WS_BBAR); float* kt = (float*)(ws + WS_KT);
    bf16_t* w1gu = (bf16_t*)(ws + WS_W1GU); bf16_t* w1d = (bf16_t*)(ws + WS_W1D); bf16_t* w2gu = (bf16_t*)(ws + WS_W2GU); bf16_t* w2d = (bf16_t*)(ws + WS_W2D);
    bf16_t* win = (bf16_t*)(ws + WS_WIN); bf16_t* wpe = (bf16_t*)(ws + WS_WPE); bf16_t* wglu = (bf16_t*)(ws + WS_WGLU); bf16_t* wmo = (bf16_t*)(ws + WS_WMO);
    bf16_t* wq = (bf16_t*)(ws + WS_WQ); bf16_t* wkv = (bf16_t*)(ws + WS_WKV); bf16_t* wxo = (bf16_t*)(ws + WS_WXO);
    bf16_t* sE = (bf16_t*)(ws + WS_SE); bf16_t* sY = (bf16_t*)(ws + WS_SY);
    bf16_t* memn = (bf16_t*)(ws + WS_MEMN); bf16_t* kb = (bf16_t*)(ws + WS_KB); bf16_t* vT = (bf16_t*)(ws + WS_VT);
    bf16_t* r1 = (bf16_t*)(ws + WS_R1);
    bf16_t* Hb = (bf16_t*)(ws + WS_HB);
    bf16_t* sg = Hb; bf16_t* pbuf = (bf16_t*)(ws + WS_HB + 128 * MiB);
    bf16_t* qb = Hb; bf16_t* Pb = (bf16_t*)(ws + WS_HB + 64 * MiB);
    bf16_t* pooled = (bf16_t*)(ws + WS_R2); bf16_t* yact = (bf16_t*)(ws + WS_R2 + 32 * MiB); float* states = (float*)(ws + WS_R2 + 48 * MiB); bf16_t* ux = (bf16_t*)(ws + WS_R2 + 56 * MiB);
    bf16_t* r3 = (bf16_t*)(ws + WS_R3);
    float* hout = a.out;

#ifndef PHMASK
#define PHMASK 0xffff
#endif
#ifndef PROBE_MODE
#define PROBE_MODE 0
#endif
#ifndef PROBE_MUL
#define PROBE_MUL 1
#endif
#ifndef PROBE_A
#define PROBE_A 0
#endif
#ifndef PROBE_B
#define PROBE_B 1
#endif
#if PROBE_MODE
    volatile LAS unsigned long long* marks = (volatile LAS unsigned long long*)(lds + 131072 + 64);
#define MARK(i) do { if (tid == 0) marks[i] = __builtin_amdgcn_s_memrealtime(); } while (0)
#else
#define MARK(i) do { } while (0)
#endif
    MARK(0);
#define IN(k) (((PHMASK >> (k)) & 1) && a.ph_lo <= (k) && (k) < a.ph_hi)
#define SEAM(k) do { MARK(1 + 2 * (k)); if (IN(k) && IN((k) + ((k) == 5 ? 2 : 1))) grid.sync(); MARK(2 + 2 * (k)); } while (0)

    if (IN(0)) {
        LAS float* scr = (LAS float*)(lds + wave * 18432);
        constexpr int I_FF = (DM / 64) * (FF / 32), I_FD = (FF / 64) * (DM / 32), I_GL = (DSSM / 64) * (DM / 32), I_SQ = (DM / 64) * (DM / 32), I_KV = (DM / 64) * (2048 / 32);
        constexpr int NITEMS = 4 * I_FF + 2 * I_FD + I_FF + 2 * I_GL + 3 * I_SQ + I_KV;
#define TR(SRC, KK, NN, DST, MODE, GK) if (!done_) { constexpr int items_ = ((KK) / 64) * ((NN) / 32); if (r < items_) { const int nblk = (NN) / 32, kb_ = r / nblk, nb_ = r % nblk, n0 = nb_ * 32; \
            d.W = SRC; d.WT = DST; d.gk = GK; d.N = NN; d.ldo = KK; d.orow = (MODE) == 0 ? n0 : (((n0 >> 7) << 8) + (n0 & 127) + ((MODE) == 2 ? 128 : 0)); d.k0 = kb_ * 64; d.n0 = n0; done_ = true; } else r -= items_; }
#define DECODE(IT, D) { TrDesc d; int r = (IT); bool done_ = false; \
            TR(a.in[3], DM, FF, w1gu, 1, a.in[2]) TR(a.in[4], DM, FF, w1gu, 2, a.in[2]) TR(a.in[5], FF, DM, w1d, 0, nullptr) \
            TR(a.in[28], DM, FF, w2gu, 1, a.in[27]) TR(a.in[29], DM, FF, w2gu, 2, a.in[27]) TR(a.in[30], FF, DM, w2d, 0, nullptr) \
            TR(a.in[7], DM, DIN, win, 0, a.in[6]) \
            TR(a.in[19], DSSM, DM, wglu, 1, nullptr) TR(a.in[20], DSSM, DM, wglu, 2, nullptr) \
            TR(a.in[21], DM, DM, wmo, 0, nullptr) TR(a.in[24], DM, DM, wq, 0, a.in[22]) TR(a.in[26], DM, DM, wxo, 0, nullptr) \
            TR(a.in[25], DM, 2048, wkv, 0, nullptr) D = d; }
        for (int it = gw; it < NITEMS; it += 2 * NGW) {
            const bool has1 = it + NGW < NITEMS;
            TrDesc d0, d1; DECODE(it, d0) DECODE(has1 ? it + NGW : it, d1)
            f32x4 v0[8], v1[8];
            tr_load(d0, v0, lane); tr_load(d1, v1, lane);
            tr_store(d0, v0, scr, lane);
            if (has1) tr_store(d1, v1, scr + 64 * 33, lane);
        }
#undef TR
#undef DECODE
        for (int mrow = gw; mrow < MTOK; mrow += 2 * NGW) {
            const int rowb = (mrow + NGW < MTOK) ? mrow + NGW : mrow;
            const f32x4* xa = (const f32x4*)(a.in[0] + (size_t)mrow * DM) + lane; const f32x4* xb_ = (const f32x4*)(a.in[0] + (size_t)rowb * DM) + lane;
            f32x4 va[4], vb[4]; float sa = 0.f, sb = 0.f;
#pragma unroll
            for (int j = 0; j < 4; ++j) { va[j] = xa[64 * j]; vb[j] = xb_[64 * j]; }
#pragma unroll
            for (int j = 0; j < 4; ++j) { sa += (va[j].x * va[j].x + va[j].y * va[j].y) + (va[j].z * va[j].z + va[j].w * va[j].w); sb += (vb[j].x * vb[j].x + vb[j].y * vb[j].y) + (vb[j].z * vb[j].z + vb[j].w * vb[j].w); }
            sa = wave_sum(sa); sb = wave_sum(sb);
            u32x2* oa = (u32x2*)(r1 + (size_t)mrow * DM) + lane; u32x2* ob = (u32x2*)(r1 + (size_t)rowb * DM) + lane;
#pragma unroll
            for (int j = 0; j < 4; ++j) { u32x2 w; w.x = cvt_pk_bf16(va[j].x, va[j].y); w.y = cvt_pk_bf16(va[j].z, va[j].w); oa[64 * j] = w; w.x = cvt_pk_bf16(vb[j].x, vb[j].y); w.y = cvt_pk_bf16(vb[j].z, vb[j].w); ob[64 * j] = w; }
            if (lane < 16) { ss0[(size_t)mrow * 16 + lane] = lane == 0 ? sa : 0.f; ss0[(size_t)rowb * 16 + lane] = lane == 0 ? sb : 0.f; }
        }
        for (int row = gw; row < MEMROWS; row += NGW) {
            const f32x4* xr = (const f32x4*)(a.in[1] + (size_t)row * DM) + lane;
            f32x4 v[4]; float s = 0.f;
#pragma unroll
            for (int j = 0; j < 4; ++j) { v[j] = xr[64 * j]; s += (v[j].x * v[j].x + v[j].y * v[j].y) + (v[j].z * v[j].z + v[j].w * v[j].w); }
            s = wave_sum(s);
            u32x2* o8 = (u32x2*)(memn + (size_t)row * DM) + lane;
            const float rs = rsqrtf(s * (1.0f / 1024.0f) + EPS); const f32x4* gr = (const f32x4*)a.in[23] + lane;
#pragma unroll
            for (int j = 0; j < 4; ++j) { const f32x4 gg = gr[64 * j]; u32x2 w; w.x = cvt_pk_bf16(v[j].x * rs * gg.x, v[j].y * rs * gg.y); w.y = cvt_pk_bf16(v[j].z * rs * gg.z, v[j].w * rs * gg.w); o8[64 * j] = w; }
        }
        if (gtid < 2048) {
            const int idx = gtid, dg = idx >> 6;
            const float dt = expf(a.in[13][dg]);
            const float ar = a.in[11][idx], ai = a.in[12][idx];
            const float mag = expf(dt * ar), ang = dt * ai;
            const float abr = mag * cosf(ang), abi = mag * sinf(ang);
            const float den = ar * ar + ai * ai, nr = abr - 1.0f;
            const float qr = (nr * ar + abi * ai) / den, qi = (abi * ar - nr * ai) / den;
            for (int h = 0; h < 16; ++h) { const float br = a.in[14][idx * 16 + h], bi = a.in[15][idx * 16 + h]; bbar[idx * 16 + h] = (f32x2){qr * br - qi * bi, qr * bi + qi * br}; }
            double pr = 1.0, pi = 0.0; const double dr = (double)abr, di = (double)abi;
            for (int t = 0; t <= 64; ++t) { pw[idx * 65 + t] = (f32x2){(float)pr, (float)pi}; const double nr2 = pr * dr - pi * di, ni2 = pr * di + pi * dr; pr = nr2; pi = ni2; }
        }
    }
    SEAM(0);

    if (IN(1)) {
        {
            LAS float* Cs = (LAS float*)lds; LAS float* Bs = Cs + 16 * 65 * 2; LAS float* Ps = Bs + 2048;
            for (int item = bx; item < 256; item += G) {
                const int dg = item >> 3, toct = item & 7;
                for (int i = tid; i < 1024; i += 512) { const int h = i >> 6, p = i & 63; Cs[(h * 65 + p) * 2] = a.in[16][dg * 1024 + i]; Cs[(h * 65 + p) * 2 + 1] = a.in[17][dg * 1024 + i];
                    const f32x2 b = bbar[dg * 1024 + i]; Bs[2 * i] = b.x; Bs[2 * i + 1] = b.y; }
                { const int p = tid >> 3, tl = tid & 7; const f32x2 w = pw[(dg * 64 + p) * 65 + toct * 8 + tl]; Ps[tid * 2] = w.x; Ps[tid * 2 + 1] = w.y; }
                __syncthreads();
                const int tl = tid >> 6, h = (tid >> 2) & 15, hq = tid & 3;
                float o0 = 0.f, o1 = 0.f, o2 = 0.f, o3 = 0.f;
#pragma unroll 4
                for (int p = 0; p < 64; ++p) {
                    const f32x2 c = *(const LAS f32x2*)(Cs + (h * 65 + p) * 2), w = *(const LAS f32x2*)(Ps + (p * 8 + tl) * 2);
                    const float cwr = c.x * w.x - c.y * w.y, cwi = c.x * w.y + c.y * w.x;
                    const f32x4 b01 = *(const LAS f32x4*)(Bs + (p * 16 + hq * 4) * 2), b23 = *(const LAS f32x4*)(Bs + (p * 16 + hq * 4 + 2) * 2);
                    o0 += cwr * b01.x - cwi * b01.y; o1 += cwr * b01.z - cwi * b01.w; o2 += cwr * b23.x - cwi * b23.y; o3 += cwr * b23.z - cwi * b23.w;
                }
                *(f32x4*)(kt + ((size_t)(dg * 64 + toct * 8 + tl)) * 256 + h * 16 + hq * 4) = (f32x4){o0, o1, o2, o3};
                __syncthreads();
            }
        }
        for (int idx = gtid; idx < 16 * 256 * 128; idx += NT) {
            const int k8 = idx & 127, j = (idx >> 7) & 255, g = idx >> 15;
            const int s = k8 >> 1, h0 = (k8 & 1) * 8, dd = j >> 7, part = (j >> 6) & 1, p = j & 63, dgp = ((dd * 16 + g) * 64 + p);
            const f32x2 w = pw[dgp * 65 + (dd == 0 ? 63 - s : s)];
            float o[8];
#pragma unroll
            for (int e = 0; e < 8; ++e) { const f32x2 b = bbar[dgp * 16 + h0 + e]; o[e] = part == 0 ? (w.x * b.x - w.y * b.y) : (w.x * b.y + w.y * b.x); }
            u32x4 v; v.x = cvt_pk_bf16(o[0], o[1]); v.y = cvt_pk_bf16(o[2], o[3]); v.z = cvt_pk_bf16(o[4], o[5]); v.w = cvt_pk_bf16(o[6], o[7]);
            *(u32x4*)(sE + ((size_t)(g * 256 + j)) * 1024 + k8 * 8) = v;
        }
        for (int idx = gtid; idx < 16 * 1024 * 32; idx += NT) {
            const int j8 = idx & 31, n = (idx >> 5) & 1023, g = idx >> 15;
            const int j0 = j8 * 8, dd = j0 >> 7, part = (j0 >> 6) & 1, p0 = j0 & 63, t = n >> 4, h = n & 15, tau = dd == 0 ? t + 1 : 64 - t;
            float o[8];
#pragma unroll
            for (int e = 0; e < 8; ++e) {
                const int p = p0 + e; const float cr = a.in[16][((dd * 16 + g) * 16 + h) * 64 + p], ci = a.in[17][((dd * 16 + g) * 16 + h) * 64 + p];
                const f32x2 w = pw[((dd * 16 + g) * 64 + p) * 65 + tau];
                o[e] = part == 0 ? (cr * w.x - ci * w.y) : -(cr * w.y + ci * w.x);
            }
            u32x4 v; v.x = cvt_pk_bf16(o[0], o[1]); v.y = cvt_pk_bf16(o[2], o[3]); v.z = cvt_pk_bf16(o[4], o[5]); v.w = cvt_pk_bf16(o[6], o[7]);
            *(u32x4*)(sY + ((size_t)(g * 1024 + n)) * UXLD + 1024 + j0) = v;
        }
        for (int idx = gtid; idx < 512 * 256; idx += NT) {
            const int n4 = (idx & 255) * 4, kc = idx >> 8, g = kc >> 7;
            const float* pwr = a.in[8] + (size_t)kc * 128; const float* psc = a.in[9] + g * 128; const float* wp = a.in[10] + (size_t)(g * 128) * DM + n4;
            f32x4 sacc = (f32x4){0.f, 0.f, 0.f, 0.f};
#pragma unroll 16
            for (int d = 0; d < 128; ++d) sacc += *(const f32x4*)(wp + (size_t)d * DM) * (pwr[d] * psc[d]);
            wpe[(size_t)(n4 + 0) * DPOOL + kc] = (bf16_t)(cvt_pk_bf16(sacc.x, 0.f) & 0xffffu); wpe[(size_t)(n4 + 1) * DPOOL + kc] = (bf16_t)(cvt_pk_bf16(sacc.y, 0.f) & 0xffffu);
            wpe[(size_t)(n4 + 2) * DPOOL + kc] = (bf16_t)(cvt_pk_bf16(sacc.z, 0.f) & 0xffffu); wpe[(size_t)(n4 + 3) * DPOOL + kc] = (bf16_t)(cvt_pk_bf16(sacc.w, 0.f) & 0xffffu);
        }
        __syncthreads();
        MARK(40);
        pg8::Gemm g{r1, w1gu, DM, DM, DM, 0, 0}; pg8::StaticOrder S; S.init(MTOK, 2 * FF, G, bx);
        pg8::EpiSwiGLU E{Hb, ss0};
        pg8::gemm_phase<pg8::EpiSwiGLU, pg8::StaticOrder, true>(lds, g, S, E);
    }
    SEAM(1);

    if (IN(2)) {
        for (int idx = gtid; idx < 16 * 1024 * 128; idx += NT) {
            const int k8 = idx & 127, n = (idx >> 7) & 1023, g = idx >> 17;
            const int s = k8 >> 1, h0 = (k8 & 1) * 8, t = n >> 4, h = n & 15;
            float o[8];
#pragma unroll
            for (int e = 0; e < 8; ++e) {
                const int h2 = h0 + e; float v = 0.f;
                if (s <= t) v += kt[((0 * 16 + g) * 64 + (t - s)) * 256 + h * 16 + h2];
                if (s >= t) v += kt[((1 * 16 + g) * 64 + (s - t)) * 256 + h * 16 + h2];
                if (s == t && h == h2) v += a.in[18][g * 16 + h];
                o[e] = v;
            }
            u32x4 v; v.x = cvt_pk_bf16(o[0], o[1]); v.y = cvt_pk_bf16(o[2], o[3]); v.z = cvt_pk_bf16(o[4], o[5]); v.w = cvt_pk_bf16(o[6], o[7]);
            *(u32x4*)(sY + ((size_t)(g * 1024 + n)) * UXLD + k8 * 8) = v;
        }
        MARK(41);
        pg8::Gemm g{Hb, w1d, FF, FF, FF, 0, 0}; pg8::StaticOrder S; S.init(MTOK, DM, G, bx);
        pg8::EpiResid<true> E{a.in[0], hout, r1, ss1, 0.5f};
        pg8::gemm_phase<pg8::EpiResid<true>, pg8::StaticOrder, true>(lds, g, S, E);
    }
    SEAM(2);

    if (IN(3)) {
        { pg8::Gemm g{r1, win, DM, DM, DM, 0, 0}; pg8::StaticOrder S; S.init(MTOK, DIN, G, bx);
          pg8::EpiWin E{pbuf, ux, sg, ss1};
          pg8::gemm_phase<pg8::EpiWin, pg8::StaticOrder, true>(lds, g, S, E); }
        {
          pg8::Gemm g{memn, wkv, DM, DM, DM, 0, 0}; pg8::StaticOrder S; S.init(MEMROWS, DM, 64, (bx >= 128 && bx < 192) ? bx - 128 : -1);
          pg8::EpiBf16<false> E{kb, DM, 0, 256, 0, nullptr, 1.0f};
          pg8::gemm_phase<pg8::EpiBf16<false>, pg8::StaticOrder, true>(lds, g, S, E); }
        {
          pg8::Gemm g{wkv + (size_t)DM * DM, memn, DM, DM, DM, 0, 0}; pg8::StaticOrder S; S.init(DM, MEMROWS, 64, (bx >= 192) ? bx - 192 : -1);
          pg8::EpiBf16<false> E{vT, 256, 1024, 0, 0, nullptr, 1.0f};
          pg8::gemm_phase<pg8::EpiBf16<false>, pg8::StaticOrder, true>(lds, g, S, E); }
    }
    SEAM(3);

    if (IN(4)) {
        const int nsb = G > 32 ? 32 : 0;
        if (bx < 32 || nsb == 0) {
            pg8::Gemm g{ux, sE, UXLD, 1024, 1024, (size_t)NCH * UXLD, (size_t)256 * 1024}; pg8::GenOrder<0> S{32, 2, 1, nsb ? 32 : G, bx};
            pg8::EpiStatesScan E{ux, pw};
            for (int i = 0;; ++i) {
                pg8::OneUnit O; O.valid = S.next(i, O.u); if (!O.valid) break;
                pg8::gemm_phase<pg8::EpiStatesScan, pg8::OneUnit, false>(lds, g, O, E);
            }
        }
        if (bx >= nsb) {
            const int wgl = (bx - nsb) * 8 + wave, nwg_ = (G - nsb) * 8;
            for (int item = wgl; item < (MTOK / 64) * 4; item += nwg_) {
                const int gi = item & 3, sg4 = item >> 2;
                const int row0 = sg4 * 64 + (lane >> 4) * 16, t0 = row0 & (SEQL - 1), ch0 = gi * 128 + (lane & 15) * 8;
                if (gi == 0) pool_strip<0>(pbuf, pooled, row0, t0, ch0);
                else if (gi == 1) pool_strip<1>(pbuf, pooled, row0, t0, ch0);
                else if (gi == 2) pool_strip<2>(pbuf, pooled, row0, t0, ch0);
                else pool_strip<3>(pbuf, pooled, row0, t0, ch0);
            }
        }
    }
    SEAM(4);

    if (IN(5)) {
        const bool split = (G == 256);
        { pg8::Gemm g{ux, sY, UXLD, UXLD, UXLD, (size_t)NCH * UXLD, (size_t)1024 * UXLD}; pg8::GenOrder<0> S{128, 2, 4, split ? 128 : G, split ? (bx < 128 ? bx : -1) : bx};
          pg8::EpiSsmY E{yact};
          pg8::gemm_phase<pg8::EpiSsmY, pg8::GenOrder<0>, true>(lds, g, S, E); }
        { pg8::Gemm g{pooled, wpe, DPOOL, DPOOL, DPOOL, 0, 0}; pg8::StaticOrder S;
          if (!split) S.init(MTOK, DM, G, bx);
          else if (bx >= 128) S.init(MTOK, DM, 128, bx - 128, 0, 3);
          else S.init(MTOK, DM, 128, bx, 384, 1);
          pg8::EpiPool E{r1, sg};
          pg8::gemm_phase<pg8::EpiPool, pg8::StaticOrder, true>(lds, g, S, E); }
    }
    SEAM(5);

    if (IN(7)) {
        pg8::Gemm g{yact, wglu, DSSM, DSSM, DSSM, 0, 0}; pg8::StaticOrder S; S.init(MTOK, 2048, G, bx);
        pg8::EpiGLU E{r3, r1, sg};
        pg8::gemm_phase<pg8::EpiGLU, pg8::StaticOrder, true>(lds, g, S, E);
    }
    SEAM(7);

    if (IN(8)) {
        pg8::Gemm g{r3, wmo, DM, DM, DM, 0, 0}; pg8::StaticOrder S; S.init(MTOK, DM, G, bx);
        pg8::EpiResid<true> E{hout, hout, r1, ss2, 1.0f};
        pg8::gemm_phase<pg8::EpiResid<true>, pg8::StaticOrder, true>(lds, g, S, E);
    }
    SEAM(8);

    if (IN(9)) {
        pg8::Gemm g{r1, wq, DM, DM, DM, 0, 0}; pg8::StaticOrder S; S.init(MTOK, DM, G, bx);
        pg8::EpiBf16<true> E{qb, DM, 0, 256, 0, ss2, 0.0625f};
        pg8::gemm_phase<pg8::EpiBf16<true>, pg8::StaticOrder, true>(lds, g, S, E);
    }
    SEAM(9);

    if (IN(10)) {
        pg8::Gemm g{qb, kb, DM, DM, 256, 256, 256}; pg8::GenOrder<1> S{512, 0, 0, G, bx};
        pg8::EpiSoftmax E{Pb};
        for (int i = 0;; ++i) {
            pg8::OneUnit O; O.valid = S.next(i, O.u); if (!O.valid) break;
            pg8::gemm_phase<pg8::EpiSoftmax, pg8::OneUnit, false>(lds, g, O, E);
        }
    }
    SEAM(10);

    if (IN(11)) {
        pg8::Gemm g{Pb, vT, DM, 256, 256, 256, 0}; pg8::GenOrder<2> S{512, 0, 0, G, bx};
        pg8::EpiBf16<false> E{r3, DM, 0, 0, 256, nullptr, 1.0f};
        pg8::gemm_phase<pg8::EpiBf16<false>, pg8::GenOrder<2>, true>(lds, g, S, E);
    }
    SEAM(11);

    if (IN(12)) {
        pg8::Gemm g{r3, wxo, DM, DM, DM, 0, 0}; pg8::StaticOrder S; S.init(MTOK, DM, G, bx);
        pg8::EpiResid<true> E{hout, hout, r1, ss3, 1.0f};
        pg8::gemm_phase<pg8::EpiResid<true>, pg8::StaticOrder, true>(lds, g, S, E);
    }
    SEAM(12);

    if (IN(13)) {
        pg8::Gemm g{r1, w2gu, DM, DM, DM, 0, 0}; pg8::StaticOrder S; S.init(MTOK, 2 * FF, G, bx);
        pg8::EpiSwiGLU E{Hb, ss3};
        pg8::gemm_phase<pg8::EpiSwiGLU, pg8::StaticOrder, true>(lds, g, S, E);
    }
    SEAM(13);

    if (IN(14)) {
        pg8::Gemm g{Hb, w2d, FF, FF, FF, 0, 0}; pg8::StaticOrder S; S.init(MTOK, DM, G, bx);
        pg8::EpiResid<false> E{hout, hout, nullptr, ss4, 0.5f};
        pg8::gemm_phase<pg8::EpiResid<false>, pg8::StaticOrder, true>(lds, g, S, E);
    }
    SEAM(14);

    if (IN(15)) {
        const f32x4* gr = (const f32x4*)a.in[31] + lane;
        f32x4 gg[4];
#pragma unroll
        for (int j = 0; j < 4; ++j) gg[j] = gr[64 * j];
        for (int row = gw; row < MTOK; row += NGW) {
            const float rs = row_rstd(ss4, row);
            f32x4* xr = (f32x4*)(hout + (size_t)row * DM) + lane;
#pragma unroll
            for (int j = 0; j < 4; ++j) { f32x4 v = xr[64 * j]; v = v * rs * gg[j]; xr[64 * j] = v; }
        }
    }
    MARK(31);
#if PROBE_MODE
    __syncthreads();
    {
        unsigned long long span = 0;
#if PROBE_MODE == 1
        span = (marks[PROBE_B] - marks[PROBE_A]) * PROBE_MUL;
#else
        for (int k = 0; k < 15; ++k) span += marks[2 + 2 * k] - marks[1 + 2 * k];
#endif
        const unsigned long long t0 = marks[31];
        while (__builtin_amdgcn_s_memrealtime() - t0 < span) __builtin_amdgcn_s_sleep(8);
    }
#endif
#undef IN
#undef SEAM
}

constexpr int LDS_BYTES = 147456;

extern "C" void kernel_launch(void* const* d_in, const int* in_sizes, int n_in, void* d_out, int out_size, void* d_ws, size_t ws_size, hipStream_t stream) {
    static int grid = 0;
    if (grid == 0) {
        if (n_in != 32 || in_sizes[0] != MTOK * DM || out_size != MTOK * DM || ws_size < WS_END) { fprintf(stderr, "kernel_launch: unexpected shapes (n_in %d, ws %zu)\n", n_in, ws_size); grid = -1; return; }
        int dev = 0, cus = 0, per_cu = 0;
        hipGetDevice(&dev); hipDeviceGetAttribute(&cus, hipDeviceAttributeMultiprocessorCount, dev);
        hipFuncSetAttribute((const void*)mk_fwd, hipFuncAttributeMaxDynamicSharedMemorySize, LDS_BYTES);
        hipOccupancyMaxActiveBlocksPerMultiprocessor(&per_cu, (const void*)mk_fwd, 512, LDS_BYTES);
        if (per_cu < 1) per_cu = 1;
        if (per_cu > 1) per_cu = 1;
        grid = cus * per_cu;
        (void)hipGetLastError();
    }
    if (grid < 0) return;
    Args a{};
    for (int i = 0; i < 32; ++i) a.in[i] = (const float*)d_in[i];
    a.out = (float*)d_out; a.ws = (unsigned char*)d_ws;
#if MK_SINGLE
    a.ph_lo = 0; a.ph_hi = NPHASE;
    void* args[] = {&a};
    hipError_t e = hipLaunchCooperativeKernel((const void*)mk_fwd, dim3(grid), dim3(512), args, LDS_BYTES, stream);
    if (e != hipSuccess) fprintf(stderr, "cooperative launch failed: %s (grid %d)\n", hipGetErrorString(e), grid);
#else
    for (int ph = 0; ph < NPHASE; ++ph) {
        a.ph_lo = ph; a.ph_hi = ph + 1;
        hipLaunchKernelGGL(mk_fwd, dim3(grid), dim3(512), LDS_BYTES, stream, a);
    }
#endif
}
```

```cpp
#include <hip/hip_runtime.h>
#include <hip/hip_cooperative_groups.h>
#include <cstdio>
#include <cstdint>
namespace cg = cooperative_groups;

#ifndef MK_SINGLE
#define MK_SINGLE 1
#endif

#define LAS __attribute__((address_space(3)))
typedef unsigned short bf16_t;
typedef short bf16x8 __attribute__((ext_vector_type(8)));
typedef float f32x4 __attribute__((ext_vector_type(4)));
typedef float f32x2 __attribute__((ext_vector_type(2)));
typedef unsigned u32x4 __attribute__((ext_vector_type(4)));
typedef unsigned u32x2 __attribute__((ext_vector_type(2)));

constexpr int MTOK = 32768, DM = 1024, FF = 2816, DIN = 2816, SEQL = 4096, NB = 8, NMEM = 256, MEMROWS = 2048;
constexpr int DPOOL = 512, DSSM = 256, NG = 16, CH = 64  , NCH = 512  , UXLD = 1280;
constexpr float EPS = 1e-6f;

constexpr size_t MiB = 1u << 20;
constexpr size_t WS_SS = 0;
constexpr size_t WS_PW = 10 * MiB;
constexpr size_t WS_BBAR = 11 * MiB + 256 * 1024;
constexpr size_t WS_KT = 12 * MiB;
constexpr size_t WS_W1GU = 14 * MiB;
constexpr size_t WS_W1D = WS_W1GU + 11 * MiB;
constexpr size_t WS_W2GU = WS_W1D + 5 * MiB + 512 * 1024;
constexpr size_t WS_W2D = WS_W2GU + 11 * MiB;
constexpr size_t WS_WIN = WS_W2D + 5 * MiB + 512 * 1024;
constexpr size_t WS_WPE = WS_WIN + 5 * MiB + 512 * 1024;
constexpr size_t WS_WGLU = WS_WPE + 1 * MiB;
constexpr size_t WS_WMO = WS_WGLU + 1 * MiB;
constexpr size_t WS_WQ = WS_WMO + 2 * MiB;
constexpr size_t WS_WKV = WS_WQ + 2 * MiB;
constexpr size_t WS_WXO = WS_WKV + 4 * MiB;
constexpr size_t WS_SE = WS_WXO + 2 * MiB;
constexpr size_t WS_SY = WS_SE + 8 * MiB;
constexpr size_t WS_MEMN = WS_SY + 40 * MiB;
constexpr size_t WS_KB = WS_MEMN + 4 * MiB;
constexpr size_t WS_VT = WS_KB + 4 * MiB;
constexpr size_t WS_R1 = WS_VT + 4 * MiB;
constexpr size_t WS_HB = WS_R1 + 64 * MiB;
constexpr size_t WS_R2 = WS_HB + 176 * MiB;
constexpr size_t WS_R3 = WS_R2 + 76 * MiB;
constexpr size_t WS_END = WS_R3 + 64 * MiB;
static_assert(WS_END <= 512 * MiB, "workspace map");

__device__ __forceinline__ unsigned cvt_pk_bf16(float lo, float hi) { unsigned r; asm volatile("v_cvt_pk_bf16_f32 %0, %1, %2" : "=v"(r) : "v"(lo), "v"(hi)); return r; }
__device__ __forceinline__ float bf_lo(unsigned w) { return __uint_as_float(w << 16); }
__device__ __forceinline__ float bf_hi(unsigned w) { return __uint_as_float(w & 0xffff0000u); }
__device__ __forceinline__ float wave_sum(float v) {
#pragma unroll
    for (int o = 1; o < 64; o <<= 1) v += __shfl_xor(v, o);
    return v;
}
__device__ __forceinline__ float sigmoid_f(float v) { return __builtin_amdgcn_rcpf(1.0f + __builtin_amdgcn_exp2f(-1.4426950408889634f * v)); }
__device__ __forceinline__ float gelu_tanh_f(float x) { const float z = 1.5957691216057308f * (x + 0.044715f * x * x * x); return x * sigmoid_f(z); }
__device__ __forceinline__ float row_rstd(const float* ss, int row) {
    const f32x4* p = (const f32x4*)(ss + (size_t)row * 16);
    const f32x4 a = p[0], b = p[1], c = p[2], d = p[3];
    const float s = ((a.x + a.y) + (a.z + a.w)) + ((b.x + b.y) + (b.z + b.w)) + ((c.x + c.y) + (c.z + c.w)) + ((d.x + d.y) + (d.z + d.w));
    return rsqrtf(s * (1.0f / 1024.0f) + EPS);
}
#define LDS_WAIT() asm volatile("s_waitcnt lgkmcnt(0)" ::: "memory")
__device__ __forceinline__ void load_rstd8(const float* ss, int row0, int fq, float (&rr)[2][4]) {
    f32x4 pv[2][4];
#pragma unroll
    for (int ai = 0; ai < 2; ++ai)
#pragma unroll
        for (int m = 0; m < 4; ++m) pv[ai][m] = *(const f32x4*)(ss + (size_t)(row0 + ai * 128 + m * 16) * 16 + fq * 4);
#pragma unroll
    for (int ai = 0; ai < 2; ++ai)
#pragma unroll
        for (int m = 0; m < 4; ++m) { float t = (pv[ai][m].x + pv[ai][m].y) + (pv[ai][m].z + pv[ai][m].w); t += __shfl_xor(t, 16); t += __shfl_xor(t, 32); rr[ai][m] = rsqrtf(t * (1.0f / 1024.0f) + EPS); }
}

namespace pg8 {
constexpr int BM = 256, BK = 64, HALF = 128, HTB = HALF * BK * 2, STAGE_BYTES = 8 * HTB, NXCD = 8, WGM = 8;
__host__ __device__ __forceinline__ int lds_byte(int r, int c) { const int st = (r >> 4) * 2 + (c >> 5), rr = r & 15, cc = c & 31, ob = rr * 64 + cc * 2; return st * 1024 + (ob ^ (((ob >> 9) & 1) << 5)); }
__host__ __device__ __forceinline__ void stage_rc(int b, int& R, int& C) { const int st = b / 1024, sb = b % 1024, swz = sb ^ (((sb >> 9) & 1) << 5); R = (st >> 1) * 16 + swz / 64; C = (st & 1) * 32 + (swz % 64) / 2; }
__host__ __device__ __forceinline__ int perm32(int rho) { const int n = rho >> 4, i = rho & 15; return 8 * (i >> 2) + 4 * n + (i & 3); }

struct Unit { int pm, pn, za, zb; };
struct Gemm { const bf16_t* A; const bf16_t* Bt; int lda, ldb, K; size_t sAz, sBz; };

struct StaticOrder {
    int nM, nN, nwg, G, c, off, imax;
    __device__ void init(int M, int N, int G_, int c_, int off_ = 0, int imax_ = 1 << 30) { nM = M / BM; nN = N / BM; nwg = nM * nN; G = G_; c = c_; off = off_; imax = imax_; }
    __device__ bool next(int i, Unit& u) const {
        if (c < 0 || i >= imax) return false;
        const long L = (long)off + (long)i * G + c; if (L >= nwg) return false;
        int wgid = (int)L; { const int q = nwg / NXCD, r = nwg % NXCD, xcd = wgid % NXCD, off = wgid / NXCD; wgid = (xcd < r ? xcd * (q + 1) : r * (q + 1) + (xcd - r) * q) + off; }
        const int nig = WGM * nN, gid = wgid / nig, fm = gid * WGM, gsz = (nM - fm) < WGM ? (nM - fm) : WGM;
        u.pm = fm + ((wgid % nig) % gsz); u.pn = (wgid % nig) / gsz; u.za = 0; u.zb = 0; return true;
    }
};
template <int KIND> struct GenOrder {
    int n, nM, nN, G, c;
    __device__ bool next(int i, Unit& u) const {
        if (c < 0) return false;
        const int L = i * G + c; if (L >= n) return false;
        if (KIND == 0) { const int per = nM * nN, z = L / per, rem = L % per; u.pm = rem % nM; u.pn = rem / nM; u.za = z; u.zb = z; }
        else if (KIND == 1) { const int h = L & 3, pm = L >> 2; u.pm = pm; u.pn = pm >> 4; u.za = h; u.zb = h; }
        else { const int h = L & 3, pm = L >> 2; u.pm = pm; u.pn = (pm >> 4) * 4 + h; u.za = h; u.zb = 0; }
        return true;
    }
};
struct OneUnit { Unit u; bool valid; __device__ bool next(int i, Unit& o) const { if (i != 0 || !valid) return false; o = u; return true; } };

__device__ __forceinline__ const char* aptr(const Gemm& g, const Unit& u) { return (const char*)g.A + ((size_t)u.pm * BM * g.lda + (size_t)u.za * g.sAz) * 2; }
__device__ __forceinline__ const char* bptr(const Gemm& g, const Unit& u) { return (const char*)g.Bt + ((size_t)u.pn * BM * g.ldb + (size_t)u.zb * g.sBz) * 2; }

template <class Epi, class Sched, bool ALIGN_EPI>
__device__ __forceinline__ void gemm_phase(LAS unsigned char* lds, const Gemm g, const Sched& S, const Epi& E) {
    const int tid = threadIdx.x, wid = __builtin_amdgcn_readfirstlane(tid >> 6), lane = tid & 63, wr = wid >> 2, wc = wid & 3, fr = lane & 15, fq = lane >> 4;
    const int K = g.K, nt = K / BK;
    unsigned voffA[2], voffB[2];
#pragma unroll
    for (int i = 0; i < 2; ++i) { int R, C; stage_rc(tid * 16 + i * 8192, R, C); const int Rb = Epi::PERM ? ((R & ~31) + perm32(R & 31)) : R;
        voffA[i] = (unsigned)(R * g.lda + C) * 2u; voffB[i] = (unsigned)(Rb * g.ldb + C) * 2u; }
    const size_t kstep = (size_t)(BK * 2);
    const size_t hstepA = (size_t)HALF * g.lda * 2, hstepB = (size_t)HALF * g.ldb * 2;
    const unsigned ldsw = (unsigned)wid * 1024u;
    const int aoff = lds_byte(wr * 64 + fr, fq * 8), boff = lds_byte(wc * 32 + fr, fq * 8);
#define PG8_SA(b, h) (((b) * 2 + (h)) * HTB)
#define PG8_SB(b, h) ((4 + (b) * 2 + (h)) * HTB)
#define PG8_STAGE(bufoff, gbase, voff) do { _Pragma("unroll") for (int _i = 0; _i < 2; ++_i) \
        __builtin_amdgcn_global_load_lds((const unsigned*)((const char*)(gbase) + (voff)[_i]), (LAS unsigned*)(lds + (bufoff) + ldsw + _i * 8192), 16, 0, 0); } while (0)
#define PG8_LDA(dst, b, h) do { _Pragma("unroll") for (int m = 0; m < 4; ++m) _Pragma("unroll") for (int k = 0; k < 2; ++k) dst[m][k] = *(const LAS bf16x8*)(lds + PG8_SA(b, h) + aoff + m * 2048 + k * 1024); } while (0)
#define PG8_LDB(dst, b, h) do { _Pragma("unroll") for (int n = 0; n < 2; ++n) _Pragma("unroll") for (int k = 0; k < 2; ++k) dst[n][k] = *(const LAS bf16x8*)(lds + PG8_SB(b, h) + boff + n * 2048 + k * 1024); } while (0)
#define PG8_MMA(ai, bj, At, Bt) do { __builtin_amdgcn_s_setprio(1); _Pragma("unroll") for (int m = 0; m < 4; ++m) _Pragma("unroll") for (int n = 0; n < 2; ++n) _Pragma("unroll") for (int k = 0; k < 2; ++k) \
        acc[ai][bj][m][n] = __builtin_amdgcn_mfma_f32_16x16x32_bf16(Bt[n][k], At[m][k], acc[ai][bj][m][n], 0, 0, 0); __builtin_amdgcn_s_setprio(0); } while (0)
#define PG8_WAIT_V(n) asm volatile("s_waitcnt vmcnt(" #n ")" ::: "memory")
#define PG8_WAIT_L(n) asm volatile("s_waitcnt lgkmcnt(" #n ")" ::: "memory")
#define PG8_BAR __builtin_amdgcn_s_barrier()
#define PG8_SCHED __builtin_amdgcn_sched_barrier(0)
    Unit cur, nxt; int ui = 0;
    if (!S.next(0, cur)) return;
    f32x4 acc[2][2][4][2];
#pragma unroll
    for (int a = 0; a < 2; ++a)
#pragma unroll
        for (int b = 0; b < 2; ++b)
#pragma unroll
            for (int m = 0; m < 4; ++m)
#pragma unroll
                for (int n = 0; n < 2; ++n) acc[a][b][m][n] = (f32x4){0.f, 0.f, 0.f, 0.f};
    bf16x8 At[4][2], B0[2][2], B1[2][2];
    const char* cA = aptr(g, cur); const char* cB = bptr(g, cur);
    PG8_STAGE(PG8_SB(0, 0), cB, voffB); PG8_STAGE(PG8_SB(0, 1), cB + hstepB, voffB); PG8_STAGE(PG8_SA(0, 0), cA, voffA); PG8_STAGE(PG8_SA(0, 1), cA + hstepA, voffA);
    if (wr == 1) PG8_BAR;
    PG8_WAIT_V(2); PG8_BAR;
    PG8_STAGE(PG8_SB(1, 0), cB + kstep, voffB); PG8_STAGE(PG8_SA(1, 0), cA + kstep, voffA); PG8_STAGE(PG8_SB(1, 1), cB + hstepB + kstep, voffB);
    PG8_WAIT_V(6); PG8_BAR;
    for (;;) {
        const bool has_next = S.next(ui + 1, nxt);
        const char* nA = has_next ? aptr(g, nxt) : cA; const char* nB = has_next ? bptr(g, nxt) : cB;
#pragma nounroll
        for (int t = 0; t < nt; t += 2) {
            const bool last = (t == nt - 2);
            const char* a1 = cA + (size_t)(t + 1) * kstep;
            const char* a2 = last ? nA : cA + (size_t)(t + 2) * kstep; const char* b2 = last ? nB : cB + (size_t)(t + 2) * kstep;
            const char* a3 = a2 + kstep; const char* b3 = b2 + kstep;
            PG8_LDB(B0, 0, 0); PG8_LDB(B1, 0, 1); PG8_SCHED; PG8_LDA(At, 0, 0); PG8_STAGE(PG8_SA(1, 1), a1 + hstepA, voffA);
            PG8_WAIT_V(8); PG8_WAIT_L(0); PG8_BAR; PG8_MMA(0, 0, At, B0); PG8_MMA(0, 1, At, B1); PG8_BAR; PG8_SCHED;
            PG8_LDA(At, 0, 1); PG8_STAGE(PG8_SB(0, 0), b2, voffB); PG8_STAGE(PG8_SB(0, 1), b2 + hstepB, voffB); PG8_STAGE(PG8_SA(0, 0), a2, voffA);
            PG8_WAIT_V(8); PG8_WAIT_L(0); PG8_BAR; PG8_MMA(1, 0, At, B0); PG8_MMA(1, 1, At, B1); PG8_BAR; PG8_SCHED;
            PG8_LDB(B0, 1, 0); PG8_LDB(B1, 1, 1); PG8_SCHED; PG8_LDA(At, 1, 0); PG8_STAGE(PG8_SA(0, 1), a2 + hstepA, voffA);
            PG8_WAIT_V(8); PG8_WAIT_L(0); PG8_BAR; PG8_MMA(0, 0, At, B0); PG8_MMA(0, 1, At, B1); PG8_BAR; PG8_SCHED;
            PG8_LDA(At, 1, 1); PG8_STAGE(PG8_SB(1, 0), b3, voffB); PG8_STAGE(PG8_SB(1, 1), b3 + hstepB, voffB); PG8_STAGE(PG8_SA(1, 0), a3, voffA);
            PG8_WAIT_V(8); PG8_WAIT_L(0); PG8_BAR; PG8_MMA(1, 0, At, B0); PG8_MMA(1, 1, At, B1); PG8_BAR; PG8_SCHED;
        }
        if constexpr (ALIGN_EPI) { if (wr == 0) PG8_BAR; }
        if constexpr (!Epi::AFTER_DRAIN) { E(acc, cur, wr, wc, fr, fq); }
        if (!has_next) break;
#pragma unroll
        for (int a = 0; a < 2; ++a)
#pragma unroll
            for (int b = 0; b < 2; ++b)
#pragma unroll
                for (int m = 0; m < 4; ++m)
#pragma unroll
                    for (int n = 0; n < 2; ++n) acc[a][b][m][n] = (f32x4){0.f, 0.f, 0.f, 0.f};
        cur = nxt; cA = nA; cB = nB; ++ui;
        if constexpr (ALIGN_EPI) { if (wr == 1) PG8_BAR; }
    }
    PG8_WAIT_V(0);
    if constexpr (!ALIGN_EPI) { if (wr == 0) PG8_BAR; }
    PG8_BAR;
    if constexpr (Epi::AFTER_DRAIN) { E.fused(acc, cur, wr, wc, fr, fq, lds, wid, lane); }
#undef PG8_SA
#undef PG8_SB
#undef PG8_STAGE
#undef PG8_LDA
#undef PG8_LDB
#undef PG8_MMA
#undef PG8_WAIT_V
#undef PG8_WAIT_L
#undef PG8_BAR
#undef PG8_SCHED
}

typedef const f32x4 (&AccRef)[2][2][4][2];

struct EpiSwiGLU {
    static constexpr bool PERM = true, AFTER_DRAIN = false;
    bf16_t* H; const float* ss;
    __device__ __forceinline__ void operator()(AccRef acc, const Unit& u, int wr, int wc, int fr, int fq) const {
        const int row0 = u.pm * BM + wr * 64 + fr, col = u.pn * 128 + wc * 32 + 8 * fq;
        float rr[2][4]; load_rstd8(ss, row0, fq, rr);
#pragma unroll
        for (int ai = 0; ai < 2; ++ai)
#pragma unroll
            for (int m = 0; m < 4; ++m) {
                const int row = row0 + ai * HALF + m * 16; const float r = rr[ai][m];
                float o[8];
#pragma unroll
                for (int n = 0; n < 2; ++n)
#pragma unroll
                    for (int j = 0; j < 4; ++j) { const float gv = acc[ai][0][m][n][j] * r, uv = acc[ai][1][m][n][j] * r; o[n * 4 + j] = gv * sigmoid_f(gv) * uv; }
                u32x4 w; w.x = cvt_pk_bf16(o[0], o[1]); w.y = cvt_pk_bf16(o[2], o[3]); w.z = cvt_pk_bf16(o[4], o[5]); w.w = cvt_pk_bf16(o[6], o[7]);
                *(u32x4*)(H + (size_t)row * FF + col) = w;
            }
    }
};
template <bool WRITE_HB> struct EpiResid {
    static constexpr bool PERM = true, AFTER_DRAIN = false;
    const float* src; float* dst; bf16_t* hb; float* ss; float alpha;
    __device__ __forceinline__ void operator()(AccRef acc, const Unit& u, int wr, int wc, int fr, int fq) const {
        const int row0 = u.pm * BM + wr * 64 + fr, col0 = u.pn * BM + wc * 32 + 8 * fq;
#pragma unroll
        for (int ai = 0; ai < 2; ++ai) {
            f32x4 b[4][2][2];
#pragma unroll
            for (int m = 0; m < 4; ++m)
#pragma unroll
                for (int bj = 0; bj < 2; ++bj) { const size_t off = (size_t)(row0 + ai * HALF + m * 16) * DM + col0 + bj * HALF; b[m][bj][0] = *(const f32x4*)(src + off); b[m][bj][1] = *(const f32x4*)(src + off + 4); }
#pragma unroll
            for (int m = 0; m < 4; ++m) {
                const int row = row0 + ai * HALF + m * 16; float q = 0.f;
#pragma unroll
                for (int bj = 0; bj < 2; ++bj) {
                    const size_t off = (size_t)row * DM + col0 + bj * HALF;
                    const f32x4 v0 = b[m][bj][0] + acc[ai][bj][m][0] * alpha, v1 = b[m][bj][1] + acc[ai][bj][m][1] * alpha;
                    *(f32x4*)(dst + off) = v0; *(f32x4*)(dst + off + 4) = v1;
                    q += (v0[0] * v0[0] + v0[1] * v0[1]) + (v0[2] * v0[2] + v0[3] * v0[3]) + (v1[0] * v1[0] + v1[1] * v1[1]) + (v1[2] * v1[2] + v1[3] * v1[3]);
                    if (WRITE_HB) { u32x4 w; w.x = cvt_pk_bf16(v0[0], v0[1]); w.y = cvt_pk_bf16(v0[2], v0[3]); w.z = cvt_pk_bf16(v1[0], v1[1]); w.w = cvt_pk_bf16(v1[2], v1[3]); *(u32x4*)(hb + off) = w; }
                }
                q += __shfl_xor(q, 16); q += __shfl_xor(q, 32);
                if (fq == 0) ss[(size_t)row * 16 + u.pn * 4 + wc] = q;
            }
            asm volatile("" ::: "memory");
        }
    }
};
struct EpiWin {
    static constexpr bool PERM = true, AFTER_DRAIN = false;
    bf16_t* p; bf16_t* ux; bf16_t* sg; const float* ss;
    __device__ __forceinline__ void operator()(AccRef acc, const Unit& u, int wr, int wc, int fr, int fq) const {
        const int row0 = u.pm * BM + wr * 64 + fr, tc0 = wc * 32 + 8 * fq;
        float rr[2][4]; load_rstd8(ss, row0, fq, rr);
#pragma unroll
        for (int ai = 0; ai < 2; ++ai)
#pragma unroll
            for (int m = 0; m < 4; ++m) {
                const int row = row0 + ai * HALF + m * 16; const float r = rr[ai][m];
#pragma unroll
                for (int bj = 0; bj < 2; ++bj) {
                    const int tc = tc0 + bj * HALF;
                    f32x4 v0 = acc[ai][bj][m][0] * r, v1 = acc[ai][bj][m][1] * r;
                    bf16_t* dst;
                    if (u.pn < 2) dst = p + (size_t)row * DPOOL + u.pn * BM + tc;
                    else if (u.pn == 2) { const int gi = tc >> 4, h0 = tc & 15; dst = ux + ((size_t)(gi * NCH + (row >> 6))) * UXLD + (row & 63) * 16 + h0; }
                    else {
                        dst = sg + (size_t)row * 2048 + (u.pn - 3) * BM + tc;
#pragma unroll
                        for (int j = 0; j < 4; ++j) { v0[j] = sigmoid_f(v0[j]); v1[j] = sigmoid_f(v1[j]); }
                    }
                    u32x4 w; w.x = cvt_pk_bf16(v0[0], v0[1]); w.y = cvt_pk_bf16(v0[2], v0[3]); w.z = cvt_pk_bf16(v1[0], v1[1]); w.w = cvt_pk_bf16(v1[2], v1[3]);
                    *(u32x4*)dst = w;
                }
            }
    }
};
struct EpiPool {
    static constexpr bool PERM = true, AFTER_DRAIN = false;
    bf16_t* zp; const bf16_t* sg;
    __device__ __forceinline__ void operator()(AccRef acc, const Unit& u, int wr, int wc, int fr, int fq) const {
        const int row0 = u.pm * BM + wr * 64 + fr, col0 = u.pn * BM + wc * 32 + 8 * fq;
#pragma unroll
        for (int ai = 0; ai < 2; ++ai) {
            u32x4 sv[4][2];
#pragma unroll
            for (int m = 0; m < 4; ++m)
#pragma unroll
                for (int bj = 0; bj < 2; ++bj) sv[m][bj] = *(const u32x4*)(sg + (size_t)(row0 + ai * HALF + m * 16) * 2048 + col0 + bj * HALF);
#pragma unroll
            for (int m = 0; m < 4; ++m)
#pragma unroll
                for (int bj = 0; bj < 2; ++bj) {
                    const u32x4 t = sv[m][bj]; const f32x4 a0 = acc[ai][bj][m][0], a1 = acc[ai][bj][m][1];
                    u32x4 w; w.x = cvt_pk_bf16(a0[0] * bf_lo(t.x), a0[1] * bf_hi(t.x)); w.y = cvt_pk_bf16(a0[2] * bf_lo(t.y), a0[3] * bf_hi(t.y));
                    w.z = cvt_pk_bf16(a1[0] * bf_lo(t.z), a1[1] * bf_hi(t.z)); w.w = cvt_pk_bf16(a1[2] * bf_lo(t.w), a1[3] * bf_hi(t.w));
                    *(u32x4*)(zp + (size_t)(row0 + ai * HALF + m * 16) * DM + col0 + bj * HALF) = w;
                }
            asm volatile("" ::: "memory");
        }
    }
};
struct EpiGLU {
    static constexpr bool PERM = true, AFTER_DRAIN = false;
    bf16_t* merged; const bf16_t* zp; const bf16_t* sg;
    __device__ __forceinline__ void operator()(AccRef acc, const Unit& u, int wr, int wc, int fr, int fq) const {
        const int row0 = u.pm * BM + wr * 64 + fr, col = u.pn * 128 + wc * 32 + 8 * fq;
#pragma unroll
        for (int ai = 0; ai < 2; ++ai) {
            u32x4 zv[4], sv[4];
#pragma unroll
            for (int m = 0; m < 4; ++m) { const int row = row0 + ai * HALF + m * 16; zv[m] = *(const u32x4*)(zp + (size_t)row * DM + col); sv[m] = *(const u32x4*)(sg + (size_t)row * 2048 + 1024 + col); }
#pragma unroll
            for (int m = 0; m < 4; ++m) {
                const int row = row0 + ai * HALF + m * 16; const u32x4 z = zv[m], t = sv[m];
                float o[8];
#pragma unroll
                for (int n = 0; n < 2; ++n)
#pragma unroll
                    for (int j = 0; j < 4; ++j) o[n * 4 + j] = acc[ai][0][m][n][j] * sigmoid_f(acc[ai][1][m][n][j]);
                u32x4 w;
                w.x = cvt_pk_bf16(bf_lo(z.x) + bf_lo(t.x) * o[0], bf_hi(z.x) + bf_hi(t.x) * o[1]);
                w.y = cvt_pk_bf16(bf_lo(z.y) + bf_lo(t.y) * o[2], bf_hi(z.y) + bf_hi(t.y) * o[3]);
                w.z = cvt_pk_bf16(bf_lo(z.z) + bf_lo(t.z) * o[4], bf_hi(z.z) + bf_hi(t.z) * o[5]);
                w.w = cvt_pk_bf16(bf_lo(z.w) + bf_lo(t.w) * o[6], bf_hi(z.w) + bf_hi(t.w) * o[7]);
                *(u32x4*)(merged + (size_t)row * DM + col) = w;
            }
            asm volatile("" ::: "memory");
        }
    }
};
template <bool HAS_SS> struct EpiBf16 {
    static constexpr bool PERM = true, AFTER_DRAIN = false;
    bf16_t* out; int ld, rowpn, colpn, colza; const float* ss; float scale;
    __device__ __forceinline__ void operator()(AccRef acc, const Unit& u, int wr, int wc, int fr, int fq) const {
        const int row0 = u.pm * BM + wr * 64 + fr + u.pn * rowpn, col0 = u.pn * colpn + u.za * colza + wc * 32 + 8 * fq;
        bf16_t* ob = out + (size_t)row0 * ld + col0;
        float rr[2][4];
        if (HAS_SS) load_rstd8(ss, u.pm * BM + wr * 64 + fr, fq, rr);
#pragma unroll
        for (int ai = 0; ai < 2; ++ai)
#pragma unroll
            for (int m = 0; m < 4; ++m) {
                float r = scale;
                if (HAS_SS) r *= rr[ai][m];
#pragma unroll
                for (int bj = 0; bj < 2; ++bj) {
                    const f32x4 v0 = acc[ai][bj][m][0] * r, v1 = acc[ai][bj][m][1] * r;
                    u32x4 w; w.x = cvt_pk_bf16(v0[0], v0[1]); w.y = cvt_pk_bf16(v0[2], v0[3]); w.z = cvt_pk_bf16(v1[0], v1[1]); w.w = cvt_pk_bf16(v1[2], v1[3]);
                    *(u32x4*)(ob + (size_t)(ai * HALF + m * 16) * ld + bj * HALF) = w;
                }
            }
    }
};
struct EpiStatesScan {
    static constexpr bool PERM = false, AFTER_DRAIN = true;
    bf16_t* ux; const f32x2* pw;
    __device__ __forceinline__ void fused(f32x4 (&acc)[2][2][4][2], const Unit& u, int wr, int wc, int fr, int fq, LAS unsigned char* lds, int wid, int lane) const {
        LAS float* T = (LAS float*)lds;
        const int tid = threadIdx.x;
#pragma unroll
        for (int half = 0; half < 2; ++half) {
#pragma unroll
            for (int ai = 0; ai < 2; ++ai)
#pragma unroll
                for (int m = 0; m < 4; ++m)
#pragma unroll
                    for (int n = 0; n < 2; ++n) *(LAS f32x4*)(T + (ai * HALF + wr * 64 + m * 16 + fr) * 132 + wc * 32 + n * 16 + 4 * fq) = acc[ai][half][m][n];
            __syncthreads();
            if (tid < 256) {
                const int b = tid >> 6, p = tid & 63;
                const f32x2 lam = pw[((half * 16 + u.za) * 64 + p) * 65 + 64];
                float xr = 0.f, xi = 0.f;
                bf16_t* ob = ux + ((size_t)(u.za * NCH + u.pm * BM + b * 64)) * UXLD + 1024 + half * 128 + p;
#pragma unroll 2
                for (int cc = 0; cc < 64; ++cc) {
                    const int c = half == 0 ? cc : 63 - cc;
                    const float sr = T[(b * 64 + c) * 132 + p], si = T[(b * 64 + c) * 132 + 64 + p];
                    ob[(size_t)c * UXLD] = (bf16_t)(cvt_pk_bf16(xr, 0.f) & 0xffffu); ob[(size_t)c * UXLD + 64] = (bf16_t)(cvt_pk_bf16(xi, 0.f) & 0xffffu);
                    const float nr = lam.x * xr - lam.y * xi + sr, ni = lam.x * xi + lam.y * xr + si; xr = nr; xi = ni;
                }
            }
            __syncthreads();
        }
    }
};
struct EpiSsmY {
    static constexpr bool PERM = true, AFTER_DRAIN = false;
    bf16_t* yact;
    __device__ __forceinline__ void operator()(AccRef acc, const Unit& u, int wr, int wc, int fr, int fq) const {
        const int row0 = u.pm * BM + wr * 64 + fr, c0 = u.pn * BM + wc * 32 + 8 * fq;
#pragma unroll
        for (int ai = 0; ai < 2; ++ai)
#pragma unroll
            for (int m = 0; m < 4; ++m) {
                const int row = row0 + ai * HALF + m * 16;
#pragma unroll
                for (int bj = 0; bj < 2; ++bj) {
                    const int c = c0 + bj * HALF, t = c >> 4, h0 = c & 15;
                    const f32x4 a0 = acc[ai][bj][m][0], a1 = acc[ai][bj][m][1];
                    u32x4 w; w.x = cvt_pk_bf16(gelu_tanh_f(a0[0]), gelu_tanh_f(a0[1])); w.y = cvt_pk_bf16(gelu_tanh_f(a0[2]), gelu_tanh_f(a0[3]));
                    w.z = cvt_pk_bf16(gelu_tanh_f(a1[0]), gelu_tanh_f(a1[1])); w.w = cvt_pk_bf16(gelu_tanh_f(a1[2]), gelu_tanh_f(a1[3]));
                    *(u32x4*)(yact + ((size_t)row * CH + t) * DSSM + u.za * 16 + h0) = w;
                }
            }
    }
};
struct EpiSoftmax {
    static constexpr bool PERM = true, AFTER_DRAIN = true;
    bf16_t* P;
    __device__ __forceinline__ void fused(f32x4 (&acc)[2][2][4][2], const Unit& u, int wr, int wc, int fr, int fq, LAS unsigned char* lds, int wid, int lane) const {
        LAS float* red = (LAS float*)lds; LAS float* red2 = (LAS float*)(lds + 4096);
#pragma unroll
        for (int ai = 0; ai < 2; ++ai)
#pragma unroll
            for (int m = 0; m < 4; ++m) {
                float mx = -3.0e38f;
#pragma unroll
                for (int bj = 0; bj < 2; ++bj)
#pragma unroll
                    for (int n = 0; n < 2; ++n)
#pragma unroll
                        for (int j = 0; j < 4; ++j) mx = fmaxf(mx, acc[ai][bj][m][n][j]);
                mx = fmaxf(mx, __shfl_xor(mx, 16)); mx = fmaxf(mx, __shfl_xor(mx, 32));
                if (fq == 0) red[(ai * HALF + wr * 64 + m * 16 + fr) * 4 + wc] = mx;
            }
        __syncthreads();
#pragma unroll
        for (int ai = 0; ai < 2; ++ai)
#pragma unroll
            for (int m = 0; m < 4; ++m) {
                const int r = ai * HALF + wr * 64 + m * 16 + fr;
                const f32x4 q = *(const LAS f32x4*)(red + r * 4);
                const float mx = fmaxf(fmaxf(q[0], q[1]), fmaxf(q[2], q[3])) * 1.4426950408889634f; float s = 0.f;
#pragma unroll
                for (int bj = 0; bj < 2; ++bj)
#pragma unroll
                    for (int n = 0; n < 2; ++n)
#pragma unroll
                        for (int j = 0; j < 4; ++j) { const float e = __builtin_amdgcn_exp2f(acc[ai][bj][m][n][j] * 1.4426950408889634f - mx); acc[ai][bj][m][n][j] = e; s += e; }
                s += __shfl_xor(s, 16); s += __shfl_xor(s, 32);
                if (fq == 0) red2[r * 4 + wc] = s;
            }
        __syncthreads();
#pragma unroll
        for (int ai = 0; ai < 2; ++ai)
#pragma unroll
            for (int m = 0; m < 4; ++m) {
                const int r = ai * HALF + wr * 64 + m * 16 + fr;
                const f32x4 q = *(const LAS f32x4*)(red2 + r * 4);
                const float inv = 1.0f / ((q[0] + q[1]) + (q[2] + q[3]));
#pragma unroll
                for (int bj = 0; bj < 2; ++bj) {
                    const f32x4 v0 = acc[ai][bj][m][0] * inv, v1 = acc[ai][bj][m][1] * inv;
                    u32x4 w; w.x = cvt_pk_bf16(v0[0], v0[1]); w.y = cvt_pk_bf16(v0[2], v0[3]); w.z = cvt_pk_bf16(v1[0], v1[1]); w.w = cvt_pk_bf16(v1[2], v1[3]);
                    *(u32x4*)(P + (size_t)(u.pm * BM + r) * DM + u.za * 256 + bj * HALF + wc * 32 + 8 * fq) = w;
                }
            }
        __syncthreads();
    }
};
}

struct TrDesc { const float* W; bf16_t* WT; const float* gk; int N, ldo, orow, k0, n0; };
__device__ __forceinline__ void tr_load(const TrDesc& d, f32x4 (&v)[8], int lane) {
    const int kr = lane >> 3, n4 = (lane & 7) * 4;
#pragma unroll
    for (int i = 0; i < 8; ++i) v[i] = *(const f32x4*)(d.W + (size_t)(d.k0 + i * 8 + kr) * d.N + d.n0 + n4);
    if (d.gk) {
#pragma unroll
        for (int i = 0; i < 8; ++i) v[i] = v[i] * d.gk[d.k0 + i * 8 + kr];
    }
}
__device__ __forceinline__ void tr_store(const TrDesc& d, const f32x4 (&v)[8], LAS float* scr, int lane) {
    const int kr = lane >> 3, n4 = (lane & 7) * 4;
#pragma unroll
    for (int i = 0; i < 8; ++i) { LAS float* q = scr + (i * 8 + kr) * 33 + n4; q[0] = v[i].x; q[1] = v[i].y; q[2] = v[i].z; q[3] = v[i].w; }
    LDS_WAIT();
    const int c = lane & 7;
#pragma unroll
    for (int j = 0; j < 4; ++j) { const int n = (lane >> 3) + 8 * j; const LAS float* t = scr + (8 * c) * 33 + n;
        u32x4 o; o.x = cvt_pk_bf16(t[0 * 33], t[1 * 33]); o.y = cvt_pk_bf16(t[2 * 33], t[3 * 33]); o.z = cvt_pk_bf16(t[4 * 33], t[5 * 33]); o.w = cvt_pk_bf16(t[6 * 33], t[7 * 33]);
        *(u32x4*)(d.WT + (size_t)(d.orow + n) * d.ldo + d.k0 + 8 * c) = o; }
    LDS_WAIT();
}
__device__ __forceinline__ u32x4 opq(u32x4 v) { asm volatile("" : "+v"(v)); return v; }
template <int GI> __device__ __forceinline__ void pool_strip(const bf16_t* pbuf, bf16_t* pooled, int row0, int t0, int ch0) {
    constexpr int W = 2 << GI, LEFT = W / 2, RIGHT = W - 1 - LEFT, NR = 16 + W - 1;
    u32x4 rows[NR];
    const bf16_t* base = pbuf + (size_t)row0 * DPOOL + ch0;
#pragma unroll
    for (int r = 0; r < NR; ++r) { const int t = t0 + r - LEFT; rows[r] = (t >= 0 && t < SEQL) ? *(const u32x4*)(base + (ptrdiff_t)(r - LEFT) * DPOOL) : (u32x4){0u, 0u, 0u, 0u}; }
    float S[8];
#pragma unroll
    for (int e = 0; e < 8; ++e) S[e] = 0.f;
#pragma unroll
    for (int r = 0; r < W; ++r) { const u32x4 v = opq(rows[r]); S[0] += bf_lo(v.x); S[1] += bf_hi(v.x); S[2] += bf_lo(v.y); S[3] += bf_hi(v.y); S[4] += bf_lo(v.z); S[5] += bf_hi(v.z); S[6] += bf_lo(v.w); S[7] += bf_hi(v.w); }
#pragma unroll
    for (int i = 0; i < 16; ++i) {
        const int t = t0 + i; const int lo = max(t - LEFT, 0), hi = min(t + RIGHT + 1, SEQL); const float inv = 1.0f / (float)(hi - lo);
        const u32x4 sv = opq(rows[i + LEFT]);
        u32x4 o; o.x = cvt_pk_bf16(S[0] * inv - bf_lo(sv.x), S[1] * inv - bf_hi(sv.x)); o.y = cvt_pk_bf16(S[2] * inv - bf_lo(sv.y), S[3] * inv - bf_hi(sv.y));
        o.z = cvt_pk_bf16(S[4] * inv - bf_lo(sv.z), S[5] * inv - bf_hi(sv.z)); o.w = cvt_pk_bf16(S[6] * inv - bf_lo(sv.w), S[7] * inv - bf_hi(sv.w));
        *(u32x4*)(pooled + (size_t)(row0 + i) * DPOOL + ch0) = o;
        if (i < 15) { const u32x4 a = opq(rows[i + W]), b = opq(rows[i]);
            S[0] += bf_lo(a.x) - bf_lo(b.x); S[1] += bf_hi(a.x) - bf_hi(b.x); S[2] += bf_lo(a.y) - bf_lo(b.y); S[3] += bf_hi(a.y) - bf_hi(b.y);
            S[4] += bf_lo(a.z) - bf_lo(b.z); S[5] += bf_hi(a.z) - bf_hi(b.z); S[6] += bf_lo(a.w) - bf_lo(b.w); S[7] += bf_hi(a.w) - bf_hi(b.w); }
    }
}

struct Args { const float* in[32]; float* out; unsigned char* ws; int ph_lo, ph_hi; };
constexpr int NPHASE = 16;

__global__ void __launch_bounds__(512, 2) mk_fwd(Args a) {
    extern __shared__ __attribute__((aligned(16))) unsigned char lds_raw[];
    LAS unsigned char* lds = (LAS unsigned char*)lds_raw;
    cg::grid_group grid = cg::this_grid();
    const int tid = threadIdx.x, lane = tid & 63, wave = __builtin_amdgcn_readfirstlane(tid >> 6);
    const int G = gridDim.x, bx = blockIdx.x;
    const int gtid = bx * 512 + tid, NT = G * 512, gw = bx * 8 + wave, NGW = G * 8;
    unsigned char* ws = a.ws;
    float* ss0 = (float*)(ws + WS_SS); float* ss1 = ss0 + (size_t)MTOK * 16; float* ss2 = ss1 + (size_t)MTOK * 16; float* ss3 = ss2 + (size_t)MTOK * 16; float* ss4 = ss3 + (size_t)MTOK * 16;
    f32x2* pw = (f32x2*)(ws + WS_PW); f32x2* bbar = (f32x2*)(ws + WS_BBAR); float* kt = (float*)(ws + WS_KT);
    bf16_t* w1gu = (bf16_t*)(ws + WS_W1GU); bf16_t* w1d = (bf16_t*)(ws + WS_W1D); bf16_t* w2gu = (bf16_t*)(ws + WS_W2GU); bf16_t* w2d = (bf16_t*)(ws + WS_W2D);
    bf16_t* win = (bf16_t*)(ws + WS_WIN); bf16_t* wpe = (bf16_t*)(ws + WS_WPE); bf16_t* wglu = (bf16_t*)(ws + WS_WGLU); bf16_t* wmo = (bf16_t*)(ws + WS_WMO);
    bf16_t* wq = (bf16_t*)(ws + WS_WQ); bf16_t* wkv = (bf16_t*)(ws + WS_WKV); bf16_t* wxo = (bf16_t*)(ws + WS_WXO);
    bf16_t* sE = (bf16_t*)(ws + WS_SE); bf16_t* sY = (bf16_t*)(ws + WS_SY);
    bf16_t* memn = (bf16_t*)(ws + WS_MEMN); bf16_t* kb = (bf16_t*)(ws + WS_KB); bf16_t* vT = (bf16_t*)(ws + WS_VT);
    bf16_t* r1 = (bf16_t*)(ws + WS_R1);
    bf16_t* Hb = (bf16_t*)(ws + WS_HB);
    bf16_t* sg = Hb; bf16_t* pbuf = (bf16_t*)(ws + WS_HB + 128 * MiB);
    bf16_t* qb = Hb; bf16_t* Pb = (bf16_t*)(ws + WS_HB + 64 * MiB);
    bf16_t* pooled = (bf16_t*)(ws + WS_R2); bf16_t* yact = (bf16_t*)(ws + WS_R2 + 32 * MiB); float* states = (float*)(ws + WS_R2 + 48 * MiB); bf16_t* ux = (bf16_t*)(ws + WS_R2 + 56 * MiB);
    bf16_t* r3 = (bf16_t*)(ws + WS_R3);
    float* hout = a.out;

#ifndef PHMASK
#define PHMASK 0xffff
#endif
#ifndef PROBE_MODE
#define PROBE_MODE 0
#endif
#ifndef PROBE_MUL
#define PROBE_MUL 1
#endif
#ifndef PROBE_A
#define PROBE_A 0
#endif
#ifndef PROBE_B
#define PROBE_B 1
#endif
#if PROBE_MODE
    volatile LAS unsigned long long* marks = (volatile LAS unsigned long long*)(lds + 147456 - 512);
#define MARK(i) do { if (tid == 0) marks[i] = __builtin_amdgcn_s_memrealtime(); } while (0)
#else
#define MARK(i) do { } while (0)
#endif
    MARK(0);
#define IN(k) (((PHMASK >> (k)) & 1) && a.ph_lo <= (k) && (k) < a.ph_hi)
#define SEAM(k) do { MARK(1 + 2 * (k)); if (IN(k) && IN((k) + ((k) == 5 ? 2 : 1))) grid.sync(); MARK(2 + 2 * (k)); } while (0)

    if (IN(0)) {
        LAS float* scr = (LAS float*)(lds + wave * 18432);
        constexpr int I_FF = (DM / 64) * (FF / 32), I_FD = (FF / 64) * (DM / 32), I_GL = (DSSM / 64) * (DM / 32), I_SQ = (DM / 64) * (DM / 32), I_KV = (DM / 64) * (2048 / 32);
        constexpr int NITEMS = 4 * I_FF + 2 * I_FD + I_FF + 2 * I_GL + 3 * I_SQ + I_KV;
#define TR(SRC, KK, NN, DST, MODE, GK) if (!done_) { constexpr int items_ = ((KK) / 64) * ((NN) / 32); if (r < items_) { const int nblk = (NN) / 32, kb_ = r / nblk, nb_ = r % nblk, n0 = nb_ * 32; \
            d.W = SRC; d.WT = DST; d.gk = GK; d.N = NN; d.ldo = KK; d.orow = (MODE) == 0 ? n0 : (((n0 >> 7) << 8) + (n0 & 127) + ((MODE) == 2 ? 128 : 0)); d.k0 = kb_ * 64; d.n0 = n0; done_ = true; } else r -= items_; }
#define DECODE(IT, D) { TrDesc d; int r = (IT); bool done_ = false; \
            TR(a.in[3], DM, FF, w1gu, 1, a.in[2]) TR(a.in[4], DM, FF, w1gu, 2, a.in[2]) TR(a.in[5], FF, DM, w1d, 0, nullptr) \
            TR(a.in[28], DM, FF, w2gu, 1, a.in[27]) TR(a.in[29], DM, FF, w2gu, 2, a.in[27]) TR(a.in[30], FF, DM, w2d, 0, nullptr) \
            TR(a.in[7], DM, DIN, win, 0, a.in[6]) \
            TR(a.in[19], DSSM, DM, wglu, 1, nullptr) TR(a.in[20], DSSM, DM, wglu, 2, nullptr) \
            TR(a.in[21], DM, DM, wmo, 0, nullptr) TR(a.in[24], DM, DM, wq, 0, a.in[22]) TR(a.in[26], DM, DM, wxo, 0, nullptr) \
            TR(a.in[25], DM, 2048, wkv, 0, nullptr) D = d; }
        for (int it = gw; it < NITEMS; it += 2 * NGW) {
            const bool has1 = it + NGW < NITEMS;
            TrDesc d0, d1; DECODE(it, d0) DECODE(has1 ? it + NGW : it, d1)
            f32x4 v0[8], v1[8];
            tr_load(d0, v0, lane); tr_load(d1, v1, lane);
            tr_store(d0, v0, scr, lane);
            if (has1) tr_store(d1, v1, scr + 64 * 33, lane);
        }
#undef TR
#undef DECODE
        for (int mrow = gw; mrow < MTOK; mrow += 2 * NGW) {
            const int rowb = (mrow + NGW < MTOK) ? mrow + NGW : mrow;
            const f32x4* xa = (const f32x4*)(a.in[0] + (size_t)mrow * DM) + lane; const f32x4* xb_ = (const f32x4*)(a.in[0] + (size_t)rowb * DM) + lane;
            f32x4 va[4], vb[4]; float sa = 0.f, sb = 0.f;
#pragma unroll
            for (int j = 0; j < 4; ++j) { va[j] = xa[64 * j]; vb[j] = xb_[64 * j]; }
#pragma unroll
            for (int j = 0; j < 4; ++j) { sa += (va[j].x * va[j].x + va[j].y * va[j].y) + (va[j].z * va[j].z + va[j].w * va[j].w); sb += (vb[j].x * vb[j].x + vb[j].y * vb[j].y) + (vb[j].z * vb[j].z + vb[j].w * vb[j].w); }
            sa = wave_sum(sa); sb = wave_sum(sb);
            u32x2* oa = (u32x2*)(r1 + (size_t)mrow * DM) + lane; u32x2* ob = (u32x2*)(r1 + (size_t)rowb * DM) + lane;
#pragma unroll
            for (int j = 0; j < 4; ++j) { u32x2 w; w.x = cvt_pk_bf16(va[j].x, va[j].y); w.y = cvt_pk_bf16(va[j].z, va[j].w); oa[64 * j] = w; w.x = cvt_pk_bf16(vb[j].x, vb[j].y); w.y = cvt_pk_bf16(vb[j].z, vb[j].w); ob[64 * j] = w; }
            if (lane < 16) { ss0[(size_t)mrow * 16 + lane] = lane == 0 ? sa : 0.f; ss0[(size_t)rowb * 16 + lane] = lane == 0 ? sb : 0.f; }
        }
        for (int row = gw; row < MEMROWS; row += NGW) {
            const f32x4* xr = (const f32x4*)(a.in[1] + (size_t)row * DM) + lane;
            f32x4 v[4]; float s = 0.f;
#pragma unroll
            for (int j = 0; j < 4; ++j) { v[j] = xr[64 * j]; s += (v[j].x * v[j].x + v[j].y * v[j].y) + (v[j].z * v[j].z + v[j].w * v[j].w); }
            s = wave_sum(s);
            u32x2* o8 = (u32x2*)(memn + (size_t)row * DM) + lane;
            const float rs = rsqrtf(s * (1.0f / 1024.0f) + EPS); const f32x4* gr = (const f32x4*)a.in[23] + lane;
#pragma unroll
            for (int j = 0; j < 4; ++j) { const f32x4 gg = gr[64 * j]; u32x2 w; w.x = cvt_pk_bf16(v[j].x * rs * gg.x, v[j].y * rs * gg.y); w.y = cvt_pk_bf16(v[j].z * rs * gg.z, v[j].w * rs * gg.w); o8[64 * j] = w; }
        }
        if (gtid < 2048) {
            const int idx = gtid, dg = idx >> 6;
            const float dt = expf(a.in[13][dg]);
            const float ar = a.in[11][idx], ai = a.in[12][idx];
            const float mag = expf(dt * ar), ang = dt * ai;
            const float abr = mag * cosf(ang), abi = mag * sinf(ang);
            const float den = ar * ar + ai * ai, nr = abr - 1.0f;
            const float qr = (nr * ar + abi * ai) / den, qi = (abi * ar - nr * ai) / den;
            for (int h = 0; h < 16; ++h) { const float br = a.in[14][idx * 16 + h], bi = a.in[15][idx * 16 + h]; bbar[idx * 16 + h] = (f32x2){qr * br - qi * bi, qr * bi + qi * br}; }
            double pr = 1.0, pi = 0.0; const double dr = (double)abr, di = (double)abi;
            for (int t = 0; t <= 64; ++t) { pw[idx * 65 + t] = (f32x2){(float)pr, (float)pi}; const double nr2 = pr * dr - pi * di, ni2 = pr * di + pi * dr; pr = nr2; pi = ni2; }
        }
    }
    SEAM(0);

    if (IN(1)) {
        {
            LAS float* Cs = (LAS float*)lds; LAS float* Bs = Cs + 16 * 65 * 2; LAS float* Ps = Bs + 2048;
            for (int item = bx; item < 256; item += G) {
                const int dg = item >> 3, toct = item & 7;
                for (int i = tid; i < 1024; i += 512) { const int h = i >> 6, p = i & 63; Cs[(h * 65 + p) * 2] = a.in[16][dg * 1024 + i]; Cs[(h * 65 + p) * 2 + 1] = a.in[17][dg * 1024 + i];
                    const f32x2 b = bbar[dg * 1024 + i]; Bs[2 * i] = b.x; Bs[2 * i + 1] = b.y; }
                { const int p = tid >> 3, tl = tid & 7; const f32x2 w = pw[(dg * 64 + p) * 65 + toct * 8 + tl]; Ps[tid * 2] = w.x; Ps[tid * 2 + 1] = w.y; }
                __syncthreads();
                const int tl = tid >> 6, h = (tid >> 2) & 15, hq = tid & 3;
                float o0 = 0.f, o1 = 0.f, o2 = 0.f, o3 = 0.f;
#pragma unroll 4
                for (int p = 0; p < 64; ++p) {
                    const f32x2 c = *(const LAS f32x2*)(Cs + (h * 65 + p) * 2), w = *(const LAS f32x2*)(Ps + (p * 8 + tl) * 2);
                    const float cwr = c.x * w.x - c.y * w.y, cwi = c.x * w.y + c.y * w.x;
                    const f32x4 b01 = *(const LAS f32x4*)(Bs + (p * 16 + hq * 4) * 2), b23 = *(const LAS f32x4*)(Bs + (p * 16 + hq * 4 + 2) * 2);
                    o0 += cwr * b01.x - cwi * b01.y; o1 += cwr * b01.z - cwi * b01.w; o2 += cwr * b23.x - cwi * b23.y; o3 += cwr * b23.z - cwi * b23.w;
                }
                *(f32x4*)(kt + ((size_t)(dg * 64 + toct * 8 + tl)) * 256 + h * 16 + hq * 4) = (f32x4){o0, o1, o2, o3};
                __syncthreads();
            }
        }
        for (int idx = gtid; idx < 16 * 256 * 128; idx += NT) {
            const int k8 = idx & 127, j = (idx >> 7) & 255, g = idx >> 15;
            const int s = k8 >> 1, h0 = (k8 & 1) * 8, dd = j >> 7, part = (j >> 6) & 1, p = j & 63, dgp = ((dd * 16 + g) * 64 + p);
            const f32x2 w = pw[dgp * 65 + (dd == 0 ? 63 - s : s)];
            float o[8];
#pragma unroll
            for (int e = 0; e < 8; ++e) { const f32x2 b = bbar[dgp * 16 + h0 + e]; o[e] = part == 0 ? (w.x * b.x - w.y * b.y) : (w.x * b.y + w.y * b.x); }
            u32x4 v; v.x = cvt_pk_bf16(o[0], o[1]); v.y = cvt_pk_bf16(o[2], o[3]); v.z = cvt_pk_bf16(o[4], o[5]); v.w = cvt_pk_bf16(o[6], o[7]);
            *(u32x4*)(sE + ((size_t)(g * 256 + j)) * 1024 + k8 * 8) = v;
        }
        for (int idx = gtid; idx < 16 * 1024 * 32; idx += NT) {
            const int j8 = idx & 31, n = (idx >> 5) & 1023, g = idx >> 15;
            const int j0 = j8 * 8, dd = j0 >> 7, part = (j0 >> 6) & 1, p0 = j0 & 63, t = n >> 4, h = n & 15, tau = dd == 0 ? t + 1 : 64 - t;
            float o[8];
#pragma unroll
            for (int e = 0; e < 8; ++e) {
                const int p = p0 + e; const float cr = a.in[16][((dd * 16 + g) * 16 + h) * 64 + p], ci = a.in[17][((dd * 16 + g) * 16 + h) * 64 + p];
                const f32x2 w = pw[((dd * 16 + g) * 64 + p) * 65 + tau];
                o[e] = part == 0 ? (cr * w.x - ci * w.y) : -(cr * w.y + ci * w.x);
            }
            u32x4 v; v.x = cvt_pk_bf16(o[0], o[1]); v.y = cvt_pk_bf16(o[2], o[3]); v.z = cvt_pk_bf16(o[4], o[5]); v.w = cvt_pk_bf16(o[6], o[7]);
            *(u32x4*)(sY + ((size_t)(g * 1024 + n)) * UXLD + 1024 + j0) = v;
        }
        for (int idx = gtid; idx < 512 * 256; idx += NT) {
            const int n4 = (idx & 255) * 4, kc = idx >> 8, g = kc >> 7;
            const float* pwr = a.in[8] + (size_t)kc * 128; const float* psc = a.in[9] + g * 128; const float* wp = a.in[10] + (size_t)(g * 128) * DM + n4;
            f32x4 sacc = (f32x4){0.f, 0.f, 0.f, 0.f};
#pragma unroll 16
            for (int d = 0; d < 128; ++d) sacc += *(const f32x4*)(wp + (size_t)d * DM) * (pwr[d] * psc[d]);
            wpe[(size_t)(n4 + 0) * DPOOL + kc] = (bf16_t)(cvt_pk_bf16(sacc.x, 0.f) & 0xffffu); wpe[(size_t)(n4 + 1) * DPOOL + kc] = (bf16_t)(cvt_pk_bf16(sacc.y, 0.f) & 0xffffu);
            wpe[(size_t)(n4 + 2) * DPOOL + kc] = (bf16_t)(cvt_pk_bf16(sacc.z, 0.f) & 0xffffu); wpe[(size_t)(n4 + 3) * DPOOL + kc] = (bf16_t)(cvt_pk_bf16(sacc.w, 0.f) & 0xffffu);
        }
        __syncthreads();
        MARK(40);
        pg8::Gemm g{r1, w1gu, DM, DM, DM, 0, 0}; pg8::StaticOrder S; S.init(MTOK, 2 * FF, G, bx);
        pg8::EpiSwiGLU E{Hb, ss0};
        pg8::gemm_phase<pg8::EpiSwiGLU, pg8::StaticOrder, true>(lds, g, S, E);
    }
    SEAM(1);

    if (IN(2)) {
        for (int idx = gtid; idx < 16 * 1024 * 128; idx += NT) {
            const int k8 = idx & 127, n = (idx >> 7) & 1023, g = idx >> 17;
            const int s = k8 >> 1, h0 = (k8 & 1) * 8, t = n >> 4, h = n & 15;
            float o[8];
#pragma unroll
            for (int e = 0; e < 8; ++e) {
                const int h2 = h0 + e; float v = 0.f;
                if (s <= t) v += kt[((0 * 16 + g) * 64 + (t - s)) * 256 + h * 16 + h2];
                if (s >= t) v += kt[((1 * 16 + g) * 64 + (s - t)) * 256 + h * 16 + h2];
                if (s == t && h == h2) v += a.in[18][g * 16 + h];
                o[e] = v;
            }
            u32x4 v; v.x = cvt_pk_bf16(o[0], o[1]); v.y = cvt_pk_bf16(o[2], o[3]); v.z = cvt_pk_bf16(o[4], o[5]); v.w = cvt_pk_bf16(o[6], o[7]);
            *(u32x4*)(sY + ((size_t)(g * 1024 + n)) * UXLD + k8 * 8) = v;
        }
        MARK(41);
        pg8::Gemm g{Hb, w1d, FF, FF, FF, 0, 0}; pg8::StaticOrder S; S.init(MTOK, DM, G, bx);
        pg8::EpiResid<true> E{a.in[0], hout, r1, ss1, 0.5f};
        pg8::gemm_phase<pg8::EpiResid<true>, pg8::StaticOrder, true>(lds, g, S, E);
    }
    SEAM(2);

    if (IN(3)) {
        { pg8::Gemm g{r1, win, DM, DM, DM, 0, 0}; pg8::StaticOrder S; S.init(MTOK, DIN, G, bx);
          pg8::EpiWin E{pbuf, ux, sg, ss1};
          pg8::gemm_phase<pg8::EpiWin, pg8::StaticOrder, true>(lds, g, S, E); }
        {
          pg8::Gemm g{memn, wkv, DM, DM, DM, 0, 0}; pg8::StaticOrder S; S.init(MEMROWS, DM, 64, (bx >= 128 && bx < 192) ? bx - 128 : -1);
          pg8::EpiBf16<false> E{kb, DM, 0, 256, 0, nullptr, 1.0f};
          pg8::gemm_phase<pg8::EpiBf16<false>, pg8::StaticOrder, true>(lds, g, S, E); }
        {
          pg8::Gemm g{wkv + (size_t)DM * DM, memn, DM, DM, DM, 0, 0}; pg8::StaticOrder S; S.init(DM, MEMROWS, 64, (bx >= 192) ? bx - 192 : -1);
          pg8::EpiBf16<false> E{vT, 256, 1024, 0, 0, nullptr, 1.0f};
          pg8::gemm_phase<pg8::EpiBf16<false>, pg8::StaticOrder, true>(lds, g, S, E); }
    }
    SEAM(3);

    if (IN(4)) {
        const int nsb = G > 32 ? 32 : 0;
        if (bx < 32 || nsb == 0) {
            pg8::Gemm g{ux, sE, UXLD, 1024, 1024, (size_t)NCH * UXLD, (size_t)256 * 1024}; pg8::GenOrder<0> S{32, 2, 1, nsb ? 32 : G, bx};
            pg8::EpiStatesScan E{ux, pw};
            for (int i = 0;; ++i) {
                pg8::OneUnit O; O.valid = S.next(i, O.u); if (!O.valid) break;
                pg8::gemm_phase<pg8::EpiStatesScan, pg8::OneUnit, false>(lds, g, O, E);
            }
        }
        if (bx >= nsb) {
            const int wgl = (bx - nsb) * 8 + wave, nwg_ = (G - nsb) * 8;
            for (int item = wgl; item < (MTOK / 64) * 4; item += nwg_) {
                const int gi = item & 3, sg4 = item >> 2;
                const int row0 = sg4 * 64 + (lane >> 4) * 16, t0 = row0 & (SEQL - 1), ch0 = gi * 128 + (lane & 15) * 8;
                if (gi == 0) pool_strip<0>(pbuf, pooled, row0, t0, ch0);
                else if (gi == 1) pool_strip<1>(pbuf, pooled, row0, t0, ch0);
                else if (gi == 2) pool_strip<2>(pbuf, pooled, row0, t0, ch0);
                else pool_strip<3>(pbuf, pooled, row0, t0, ch0);
            }
        }
    }
    SEAM(4);

    if (IN(5)) {
        const bool split = (G == 256);
        { pg8::Gemm g{ux, sY, UXLD, UXLD, UXLD, (size_t)NCH * UXLD, (size_t)1024 * UXLD}; pg8::GenOrder<0> S{128, 2, 4, split ? 128 : G, split ? (bx < 128 ? bx : -1) : bx};
          pg8::EpiSsmY E{yact};
          pg8::gemm_phase<pg8::EpiSsmY, pg8::GenOrder<0>, true>(lds, g, S, E); }
        { pg8::Gemm g{pooled, wpe, DPOOL, DPOOL, DPOOL, 0, 0}; pg8::StaticOrder S;
          if (!split) S.init(MTOK, DM, G, bx);
          else if (bx >= 128) S.init(MTOK, DM, 128, bx - 128, 0, 3);
          else S.init(MTOK, DM, 128, bx, 384, 1);
          pg8::EpiPool E{r1, sg};
          pg8::gemm_phase<pg8::EpiPool, pg8::StaticOrder, true>(lds, g, S, E); }
    }
    SEAM(5);

    if (IN(7)) {
        pg8::Gemm g{yact, wglu, DSSM, DSSM, DSSM, 0, 0}; pg8::StaticOrder S; S.init(MTOK, 2048, G, bx);
        pg8::EpiGLU E{r3, r1, sg};
        pg8::gemm_phase<pg8::EpiGLU, pg8::StaticOrder, true>(lds, g, S, E);
    }
    SEAM(7);

    if (IN(8)) {
        pg8::Gemm g{r3, wmo, DM, DM, DM, 0, 0}; pg8::StaticOrder S; S.init(MTOK, DM, G, bx);
        pg8::EpiResid<true> E{hout, hout, r1, ss2, 1.0f};
        pg8::gemm_phase<pg8::EpiResid<true>, pg8::StaticOrder, true>(lds, g, S, E);
    }
    SEAM(8);

    if (IN(9)) {
        pg8::Gemm g{r1, wq, DM, DM, DM, 0, 0}; pg8::StaticOrder S; S.init(MTOK, DM, G, bx);
        pg8::EpiBf16<true> E{qb, DM, 0, 256, 0, ss2, 0.0625f};
        pg8::gemm_phase<pg8::EpiBf16<true>, pg8::StaticOrder, true>(lds, g, S, E);
    }
    SEAM(9);

    if (IN(10)) {
        pg8::Gemm g{qb, kb, DM, DM, 256, 256, 256}; pg8::GenOrder<1> S{512, 0, 0, G, bx};
        pg8::EpiSoftmax E{Pb};
        for (int i = 0;; ++i) {
            pg8::OneUnit O; O.valid = S.next(i, O.u); if (!O.valid) break;
            pg8::gemm_phase<pg8::EpiSoftmax, pg8::OneUnit, false>(lds, g, O, E);
        }
    }
    SEAM(10);

    if (IN(11)) {
        pg8::Gemm g{Pb, vT, DM, 256, 256, 256, 0}; pg8::GenOrder<2> S{512, 0, 0, G, bx};
        pg8::EpiBf16<false> E{r3, DM, 0, 0, 256, nullptr, 1.0f};
        pg8::gemm_phase<pg8::EpiBf16<false>, pg8::GenOrder<2>, true>(lds, g, S, E);
    }
    SEAM(11);

    if (IN(12)) {
        pg8::Gemm g{r3, wxo, DM, DM, DM, 0, 0}; pg8::StaticOrder S; S.init(MTOK, DM, G, bx);
        pg8::EpiResid<true> E{hout, hout, r1, ss3, 1.0f};
        pg8::gemm_phase<pg8::EpiResid<true>, pg8::StaticOrder, true>(lds, g, S, E);
    }
    SEAM(12);

    if (IN(13)) {
        pg8::Gemm g{r1, w2gu, DM, DM, DM, 0, 0}; pg8::StaticOrder S; S.init(MTOK, 2 * FF, G, bx);
        pg8::EpiSwiGLU E{Hb, ss3};
        pg8::gemm_phase<pg8::EpiSwiGLU, pg8::StaticOrder, true>(lds, g, S, E);
    }
    SEAM(13);

    if (IN(14)) {
        pg8::Gemm g{Hb, w2d, FF, FF, FF, 0, 0}; pg8::StaticOrder S; S.init(MTOK, DM, G, bx);
        pg8::EpiResid<false> E{hout, hout, nullptr, ss4, 0.5f};
        pg8::gemm_phase<pg8::EpiResid<false>, pg8::StaticOrder, true>(lds, g, S, E);
    }
    SEAM(14);

    if (IN(15)) {
        const f32x4* gr = (const f32x4*)a.in[31] + lane;
        f32x4 gg[4];
#pragma unroll
        for (int j = 0; j < 4; ++j) gg[j] = gr[64 * j];
        for (int row = gw; row < MTOK; row += NGW) {
            const float rs = row_rstd(ss4, row);
            f32x4* xr = (f32x4*)(hout + (size_t)row * DM) + lane;
#pragma unroll
            for (int j = 0; j < 4; ++j) { f32x4 v = xr[64 * j]; v = v * rs * gg[j]; xr[64 * j] = v; }
        }
    }
    MARK(31);
#if PROBE_MODE
    __syncthreads();
    {
        unsigned long long span = 0;
#if PROBE_MODE == 1
        span = (marks[PROBE_B] - marks[PROBE_A]) * PROBE_MUL;
#else
        for (int k = 0; k < 15; ++k) span += marks[2 + 2 * k] - marks[1 + 2 * k];
#endif
        const unsigned long long t0 = marks[31];
        while (__builtin_amdgcn_s_memrealtime() - t0 < span) __builtin_amdgcn_s_sleep(8);
    }
#endif
#undef IN
#undef SEAM
}

constexpr int LDS_BYTES = 147456;

extern "C" void kernel_launch(void* const* d_in, const int* in_sizes, int n_in, void* d_out, int out_size, void* d_ws, size_t ws_size, hipStream_t stream) {
    static int grid = 0;
    if (grid == 0) {
        if (n_in != 32 || in_sizes[0] != MTOK * DM || out_size != MTOK * DM || ws_size < WS_END) { fprintf(stderr, "kernel_launch: unexpected shapes (n_in %d, ws %zu)\n", n_in, ws_size); grid = -1; return; }
        int dev = 0, cus = 0, per_cu = 0;
        hipGetDevice(&dev); hipDeviceGetAttribute(&cus, hipDeviceAttributeMultiprocessorCount, dev);
        hipFuncSetAttribute((const void*)mk_fwd, hipFuncAttributeMaxDynamicSharedMemorySize, LDS_BYTES);
        hipOccupancyMaxActiveBlocksPerMultiprocessor(&per_cu, (const void*)mk_fwd, 512, LDS_BYTES);
        if (per_cu < 1) per_cu = 1;
        if (per_cu > 1) per_cu = 1;
        grid = cus * per_cu;
        (void)hipGetLastError();
    }
    if (grid < 0) return;
    Args a{};
    for (int i = 0; i < 32; ++i) a.in[i] = (const float*)d_in[i];
    a.out = (float*)d_out; a.ws = (unsigned char*)d_ws;
#if MK_SINGLE
    a.ph_lo = 0; a.ph_hi = NPHASE;
    void* args[] = {&a};
    hipError_t e = hipLaunchCooperativeKernel((const void*)mk_fwd, dim3(grid), dim3(512), args, LDS_BYTES, stream);
    if (e != hipSuccess) fprintf(stderr, "cooperative launch failed: %s (grid %d)\n", hipGetErrorString(e), grid);
#else
    for (int ph = 0; ph < NPHASE; ++ph) {
        a.ph_lo = ph; a.ph_hi = ph + 1;
        hipLaunchKernelGGL(mk_fwd, dim3(grid), dim3(512), LDS_BYTES, stream, a);
    }
#endif
}
```

```cpp
#include <hip/hip_runtime.h>
#include <hip/hip_cooperative_groups.h>
#include <cstdio>
#include <cstdint>
namespace cg = cooperative_groups;

#ifndef MK_SINGLE
#define MK_SINGLE 1
#endif

#define LAS __attribute__((address_space(3)))
typedef unsigned short bf16_t;
typedef short bf16x8 __attribute__((ext_vector_type(8)));
typedef float f32x4 __attribute__((ext_vector_type(4)));
typedef float f32x2 __attribute__((ext_vector_type(2)));
typedef unsigned u32x4 __attribute__((ext_vector_type(4)));
typedef unsigned u32x2 __attribute__((ext_vector_type(2)));

constexpr int MTOK = 32768, DM = 1024, FF = 2816, DIN = 2816, SEQL = 4096, NB = 8, NMEM = 256, MEMROWS = 2048;
constexpr int DPOOL = 512, DSSM = 256, NG = 16, CH = 64  , NCH = 512  , UXLD = 1280;
constexpr float EPS = 1e-6f;

constexpr size_t MiB = 1u << 20;
constexpr size_t WS_SS = 0;
constexpr size_t WS_PW = 10 * MiB;
constexpr size_t WS_BBAR = 11 * MiB + 256 * 1024;
constexpr size_t WS_KT = 12 * MiB;
constexpr size_t WS_W1GU = 14 * MiB;
constexpr size_t WS_W1D = WS_W1GU + 11 * MiB;
constexpr size_t WS_W2GU = WS_W1D + 5 * MiB + 512 * 1024;
constexpr size_t WS_W2D = WS_W2GU + 11 * MiB;
constexpr size_t WS_WIN = WS_W2D + 5 * MiB + 512 * 1024;
constexpr size_t WS_WPE = WS_WIN + 5 * MiB + 512 * 1024;
constexpr size_t WS_WGLU = WS_WPE + 1 * MiB;
constexpr size_t WS_WMO = WS_WGLU + 1 * MiB;
constexpr size_t WS_WQ = WS_WMO + 2 * MiB;
constexpr size_t WS_WKV = WS_WQ + 2 * MiB;
constexpr size_t WS_WXO = WS_WKV + 4 * MiB;
constexpr size_t WS_SE = WS_WXO + 2 * MiB;
constexpr size_t WS_SY = WS_SE + 8 * MiB;
constexpr size_t WS_MEMN = WS_SY + 40 * MiB;
constexpr size_t WS_KB = WS_MEMN + 4 * MiB;
constexpr size_t WS_VT = WS_KB + 4 * MiB;
constexpr size_t WS_R1 = WS_VT + 4 * MiB;
constexpr size_t WS_HB = WS_R1 + 64 * MiB;
constexpr size_t WS_R2 = WS_HB + 176 * MiB;
constexpr size_t WS_R3 = WS_R2 + 76 * MiB;
constexpr size_t WS_CTL = WS_R3 + 64 * MiB;
constexpr size_t CTL_BYTES = 16384;
constexpr size_t WS_END = WS_CTL + 65536;
static_assert(WS_END <= 512 * MiB, "workspace map");

__device__ __forceinline__ unsigned cvt_pk_bf16(float lo, float hi) { unsigned r; asm volatile("v_cvt_pk_bf16_f32 %0, %1, %2" : "=v"(r) : "v"(lo), "v"(hi)); return r; }
__device__ __forceinline__ float bf_lo(unsigned w) { return __uint_as_float(w << 16); }
__device__ __forceinline__ float bf_hi(unsigned w) { return __uint_as_float(w & 0xffff0000u); }
__device__ __forceinline__ float wave_sum(float v) {
#pragma unroll
    for (int o = 1; o < 64; o <<= 1) v += __shfl_xor(v, o);
    return v;
}
__device__ __forceinline__ float sigmoid_f(float v) { return __builtin_amdgcn_rcpf(1.0f + __builtin_amdgcn_exp2f(-1.4426950408889634f * v)); }
__device__ __forceinline__ float gelu_tanh_f(float x) { const float z = 1.5957691216057308f * (x + 0.044715f * x * x * x); return x * sigmoid_f(z); }
__device__ __forceinline__ float row_rstd(const float* ss, int row) {
    const f32x4* p = (const f32x4*)(ss + (size_t)row * 16);
    const f32x4 a = p[0], b = p[1], c = p[2], d = p[3];
    const float s = ((a.x + a.y) + (a.z + a.w)) + ((b.x + b.y) + (b.z + b.w)) + ((c.x + c.y) + (c.z + c.w)) + ((d.x + d.y) + (d.z + d.w));
    return rsqrtf(s * (1.0f / 1024.0f) + EPS);
}
#define LDS_WAIT() asm volatile("s_waitcnt lgkmcnt(0)" ::: "memory")
__device__ __forceinline__ void load_rstd8(const float* ss, int row0, int fq, float (&rr)[2][4]) {
    f32x4 pv[2][4];
#pragma unroll
    for (int ai = 0; ai < 2; ++ai)
#pragma unroll
        for (int m = 0; m < 4; ++m) pv[ai][m] = *(const f32x4*)(ss + (size_t)(row0 + ai * 128 + m * 16) * 16 + fq * 4);
#pragma unroll
    for (int ai = 0; ai < 2; ++ai)
#pragma unroll
        for (int m = 0; m < 4; ++m) { float t = (pv[ai][m].x + pv[ai][m].y) + (pv[ai][m].z + pv[ai][m].w); t += __shfl_xor(t, 16); t += __shfl_xor(t, 32); rr[ai][m] = rsqrtf(t * (1.0f / 1024.0f) + EPS); }
}

namespace pg8 {
constexpr int BM = 256, BK = 64, HALF = 128, HTB = HALF * BK * 2, STAGE_BYTES = 8 * HTB, NXCD = 8, WGM = 8;
__host__ __device__ __forceinline__ int lds_byte(int r, int c) { const int st = (r >> 4) * 2 + (c >> 5), rr = r & 15, cc = c & 31, ob = rr * 64 + cc * 2; return st * 1024 + (ob ^ (((ob >> 9) & 1) << 5)); }
__host__ __device__ __forceinline__ void stage_rc(int b, int& R, int& C) { const int st = b / 1024, sb = b % 1024, swz = sb ^ (((sb >> 9) & 1) << 5); R = (st >> 1) * 16 + swz / 64; C = (st & 1) * 32 + (swz % 64) / 2; }
__host__ __device__ __forceinline__ int perm32(int rho) { const int n = rho >> 4, i = rho & 15; return 8 * (i >> 2) + 4 * n + (i & 3); }

struct Unit { int pm, pn, za, zb; };
struct Gemm { const bf16_t* A; const bf16_t* Bt; int lda, ldb, K; size_t sAz, sBz; };

struct StaticOrder {
    int nM, nN, nwg, G, c, off, imax;
    __device__ __forceinline__ void init(int M, int N, int G_, int c_, int off_ = 0, int imax_ = 1 << 30) { nM = M / BM; nN = N / BM; nwg = nM * nN; G = G_; c = c_; off = off_; imax = imax_; }
    __device__ __forceinline__ bool next(int i, Unit& u) const {
        if (c < 0 || i >= imax) return false;
        const long L = (long)off + (long)i * G + c; if (L >= nwg) return false;
        int wgid = (int)L; { const int q = nwg / NXCD, r = nwg % NXCD, xcd = wgid % NXCD, off = wgid / NXCD; wgid = (xcd < r ? xcd * (q + 1) : r * (q + 1) + (xcd - r) * q) + off; }
        const int nig = WGM * nN, gid = wgid / nig, fm = gid * WGM, gsz = (nM - fm) < WGM ? (nM - fm) : WGM;
        u.pm = fm + ((wgid % nig) % gsz); u.pn = (wgid % nig) / gsz; u.za = 0; u.zb = 0; return true;
    }
};
template <int KIND> struct GenOrder {
    int n, nM, nN, G, c;
    __device__ __forceinline__ bool next(int i, Unit& u) const {
        if (c < 0) return false;
        const int L = i * G + c; if (L >= n) return false;
        if (KIND == 0) { const int per = nM * nN, z = L / per, rem = L % per; u.pm = rem % nM; u.pn = rem / nM; u.za = z; u.zb = z; }
        else if (KIND == 1) { const int h = L & 3, pm = L >> 2; u.pm = pm; u.pn = pm >> 4; u.za = h; u.zb = h; }
        else { const int h = L & 3, pm = L >> 2; u.pm = pm; u.pn = (pm >> 4) * 4 + h; u.za = h; u.zb = 0; }
        return true;
    }
};
struct OneUnit { Unit u; bool valid; __device__ __forceinline__ bool next(int i, Unit& o) const { if (i != 0 || !valid) return false; o = u; return true; } };

__device__ __forceinline__ const char* aptr(const Gemm& g, const Unit& u) { return (const char*)g.A + ((size_t)u.pm * BM * g.lda + (size_t)u.za * g.sAz) * 2; }
__device__ __forceinline__ const char* bptr(const Gemm& g, const Unit& u) { return (const char*)g.Bt + ((size_t)u.pn * BM * g.ldb + (size_t)u.zb * g.sBz) * 2; }

template <class Epi, class Sched, bool ALIGN_EPI>
__device__ __forceinline__ void gemm_phase(LAS unsigned char* lds, const Gemm g, const Sched& S, const Epi& E) {
    const int tid = threadIdx.x, wid = __builtin_amdgcn_readfirstlane(tid >> 6), lane = tid & 63, wr = wid >> 2, wc = wid & 3, fr = lane & 15, fq = lane >> 4;
    const int K = g.K, nt = K / BK;
    unsigned voffA[2], voffB[2];
#pragma unroll
    for (int i = 0; i < 2; ++i) { int R, C; stage_rc(tid * 16 + i * 8192, R, C); const int Rb = Epi::PERM ? ((R & ~31) + perm32(R & 31)) : R;
        voffA[i] = (unsigned)(R * g.lda + C) * 2u; voffB[i] = (unsigned)(Rb * g.ldb + C) * 2u; }
    const size_t kstep = (size_t)(BK * 2);
    const size_t hstepA = (size_t)HALF * g.lda * 2, hstepB = (size_t)HALF * g.ldb * 2;
    const unsigned ldsw = (unsigned)wid * 1024u;
    const int aoff = lds_byte(wr * 64 + fr, fq * 8), boff = lds_byte(wc * 32 + fr, fq * 8);
#define PG8_SA(b, h) (((b) * 2 + (h)) * HTB)
#define PG8_SB(b, h) ((4 + (b) * 2 + (h)) * HTB)
#define PG8_STAGE(bufoff, gbase, voff) do { _Pragma("unroll") for (int _i = 0; _i < 2; ++_i) \
        __builtin_amdgcn_global_load_lds((const unsigned*)((const char*)(gbase) + (voff)[_i]), (LAS unsigned*)(lds + (bufoff) + ldsw + _i * 8192), 16, 0, 0); } while (0)
#define PG8_LDA(dst, b, h) do { _Pragma("unroll") for (int m = 0; m < 4; ++m) _Pragma("unroll") for (int k = 0; k < 2; ++k) dst[m][k] = *(const LAS bf16x8*)(lds + PG8_SA(b, h) + aoff + m * 2048 + k * 1024); } while (0)
#define PG8_LDB(dst, b, h) do { _Pragma("unroll") for (int n = 0; n < 2; ++n) _Pragma("unroll") for (int k = 0; k < 2; ++k) dst[n][k] = *(const LAS bf16x8*)(lds + PG8_SB(b, h) + boff + n * 2048 + k * 1024); } while (0)
#define PG8_MMA(ai, bj, At, Bt) do { __builtin_amdgcn_s_setprio(1); _Pragma("unroll") for (int m = 0; m < 4; ++m) _Pragma("unroll") for (int n = 0; n < 2; ++n) _Pragma("unroll") for (int k = 0; k < 2; ++k) \
        acc[ai][bj][m][n] = __builtin_amdgcn_mfma_f32_16x16x32_bf16(Bt[n][k], At[m][k], acc[ai][bj][m][n], 0, 0, 0); __builtin_amdgcn_s_setprio(0); } while (0)
#define PG8_WAIT_V(n) asm volatile("s_waitcnt vmcnt(" #n ")" ::: "memory")
#define PG8_WAIT_L(n) asm volatile("s_waitcnt lgkmcnt(" #n ")" ::: "memory")
#define PG8_BAR __builtin_amdgcn_s_barrier()
#define PG8_SCHED __builtin_amdgcn_sched_barrier(0)
    Unit cur, nxt; int ui = 0;
    if (!S.next(0, cur)) return;
    f32x4 acc[2][2][4][2];
#pragma unroll
    for (int a = 0; a < 2; ++a)
#pragma unroll
        for (int b = 0; b < 2; ++b)
#pragma unroll
            for (int m = 0; m < 4; ++m)
#pragma unroll
                for (int n = 0; n < 2; ++n) acc[a][b][m][n] = (f32x4){0.f, 0.f, 0.f, 0.f};
    bf16x8 At[4][2], B0[2][2], B1[2][2];
    const char* cA = aptr(g, cur); const char* cB = bptr(g, cur);
    PG8_STAGE(PG8_SB(0, 0), cB, voffB); PG8_STAGE(PG8_SB(0, 1), cB + hstepB, voffB); PG8_STAGE(PG8_SA(0, 0), cA, voffA); PG8_STAGE(PG8_SA(0, 1), cA + hstepA, voffA);
    if (wr == 1) PG8_BAR;
    PG8_WAIT_V(2); PG8_BAR;
    PG8_STAGE(PG8_SB(1, 0), cB + kstep, voffB); PG8_STAGE(PG8_SA(1, 0), cA + kstep, voffA); PG8_STAGE(PG8_SB(1, 1), cB + hstepB + kstep, voffB);
    PG8_WAIT_V(6); PG8_BAR;
    for (;;) {
        const bool has_next = S.next(ui + 1, nxt);
        const char* nA = has_next ? aptr(g, nxt) : cA; const char* nB = has_next ? bptr(g, nxt) : cB;
#pragma nounroll
        for (int t = 0; t < nt; t += 2) {
            const bool last = (t == nt - 2);
            const char* a1 = cA + (size_t)(t + 1) * kstep;
            const char* a2 = last ? nA : cA + (size_t)(t + 2) * kstep; const char* b2 = last ? nB : cB + (size_t)(t + 2) * kstep;
            const char* a3 = a2 + kstep; const char* b3 = b2 + kstep;
            PG8_LDB(B0, 0, 0); PG8_LDB(B1, 0, 1); PG8_SCHED; PG8_LDA(At, 0, 0); PG8_STAGE(PG8_SA(1, 1), a1 + hstepA, voffA);
            PG8_WAIT_V(8); PG8_WAIT_L(0); PG8_BAR; PG8_MMA(0, 0, At, B0); PG8_MMA(0, 1, At, B1); PG8_BAR; PG8_SCHED;
            PG8_LDA(At, 0, 1); PG8_STAGE(PG8_SB(0, 0), b2, voffB); PG8_STAGE(PG8_SB(0, 1), b2 + hstepB, voffB); PG8_STAGE(PG8_SA(0, 0), a2, voffA);
            PG8_WAIT_V(8); PG8_WAIT_L(0); PG8_BAR; PG8_MMA(1, 0, At, B0); PG8_MMA(1, 1, At, B1); PG8_BAR; PG8_SCHED;
            PG8_LDB(B0, 1, 0); PG8_LDB(B1, 1, 1); PG8_SCHED; PG8_LDA(At, 1, 0); PG8_STAGE(PG8_SA(0, 1), a2 + hstepA, voffA);
            PG8_WAIT_V(8); PG8_WAIT_L(0); PG8_BAR; PG8_MMA(0, 0, At, B0); PG8_MMA(0, 1, At, B1); PG8_BAR; PG8_SCHED;
            PG8_LDA(At, 1, 1); PG8_STAGE(PG8_SB(1, 0), b3, voffB); PG8_STAGE(PG8_SB(1, 1), b3 + hstepB, voffB); PG8_STAGE(PG8_SA(1, 0), a3, voffA);
            PG8_WAIT_V(8); PG8_WAIT_L(0); PG8_BAR; PG8_MMA(1, 0, At, B0); PG8_MMA(1, 1, At, B1); PG8_BAR; PG8_SCHED;
        }
        if constexpr (ALIGN_EPI) { if (wr == 0) PG8_BAR; }
        if constexpr (!Epi::AFTER_DRAIN) { E(acc, cur, wr, wc, fr, fq); }
        if (!has_next) break;
#pragma unroll
        for (int a = 0; a < 2; ++a)
#pragma unroll
            for (int b = 0; b < 2; ++b)
#pragma unroll
                for (int m = 0; m < 4; ++m)
#pragma unroll
                    for (int n = 0; n < 2; ++n) acc[a][b][m][n] = (f32x4){0.f, 0.f, 0.f, 0.f};
        cur = nxt; cA = nA; cB = nB; ++ui;
        if constexpr (ALIGN_EPI) { if (wr == 1) PG8_BAR; }
    }
    PG8_WAIT_V(0);
    if constexpr (!ALIGN_EPI) { if (wr == 0) PG8_BAR; }
    PG8_BAR;
    if constexpr (Epi::AFTER_DRAIN) { E.fused(acc, cur, wr, wc, fr, fq, lds, wid, lane); }
#undef PG8_SA
#undef PG8_SB
#undef PG8_STAGE
#undef PG8_LDA
#undef PG8_LDB
#undef PG8_MMA
#undef PG8_WAIT_V
#undef PG8_WAIT_L
#undef PG8_BAR
#undef PG8_SCHED
}

typedef const f32x4 (&AccRef)[2][2][4][2];

struct EpiSwiGLU {
    static constexpr bool PERM = true, AFTER_DRAIN = false;
    bf16_t* H; const float* ss;
    __device__ __forceinline__ void operator()(AccRef acc, const Unit& u, int wr, int wc, int fr, int fq) const {
        const int row0 = u.pm * BM + wr * 64 + fr, col = u.pn * 128 + wc * 32 + 8 * fq;
        float rr[2][4]; load_rstd8(ss, row0, fq, rr);
#pragma unroll
        for (int ai = 0; ai < 2; ++ai)
#pragma unroll
            for (int m = 0; m < 4; ++m) {
                const int row = row0 + ai * HALF + m * 16; const float r = rr[ai][m];
                float o[8];
#pragma unroll
                for (int n = 0; n < 2; ++n)
#pragma unroll
                    for (int j = 0; j < 4; ++j) { const float gv = acc[ai][0][m][n][j] * r, uv = acc[ai][1][m][n][j] * r; o[n * 4 + j] = gv * sigmoid_f(gv) * uv; }
                u32x4 w; w.x = cvt_pk_bf16(o[0], o[1]); w.y = cvt_pk_bf16(o[2], o[3]); w.z = cvt_pk_bf16(o[4], o[5]); w.w = cvt_pk_bf16(o[6], o[7]);
                *(u32x4*)(H + (size_t)row * FF + col) = w;
            }
    }
};
template <bool WRITE_HB> struct EpiResid {
    static constexpr bool PERM = true, AFTER_DRAIN = false;
    const float* src; float* dst; bf16_t* hb; float* ss; float alpha;
    __device__ __forceinline__ void operator()(AccRef acc, const Unit& u, int wr, int wc, int fr, int fq) const {
        const int row0 = u.pm * BM + wr * 64 + fr, col0 = u.pn * BM + wc * 32 + 8 * fq;
#pragma unroll
        for (int ai = 0; ai < 2; ++ai) {
            f32x4 b[4][2][2];
#pragma unroll
            for (int m = 0; m < 4; ++m)
#pragma unroll
                for (int bj = 0; bj < 2; ++bj) { const size_t off = (size_t)(row0 + ai * HALF + m * 16) * DM + col0 + bj * HALF; b[m][bj][0] = *(const f32x4*)(src + off); b[m][bj][1] = *(const f32x4*)(src + off + 4); }
#pragma unroll
            for (int m = 0; m < 4; ++m) {
                const int row = row0 + ai * HALF + m * 16; float q = 0.f;
#pragma unroll
                for (int bj = 0; bj < 2; ++bj) {
                    const size_t off = (size_t)row * DM + col0 + bj * HALF;
                    const f32x4 v0 = b[m][bj][0] + acc[ai][bj][m][0] * alpha, v1 = b[m][bj][1] + acc[ai][bj][m][1] * alpha;
                    *(f32x4*)(dst + off) = v0; *(f32x4*)(dst + off + 4) = v1;
                    q += (v0[0] * v0[0] + v0[1] * v0[1]) + (v0[2] * v0[2] + v0[3] * v0[3]) + (v1[0] * v1[0] + v1[1] * v1[1]) + (v1[2] * v1[2] + v1[3] * v1[3]);
                    if (WRITE_HB) { u32x4 w; w.x = cvt_pk_bf16(v0[0], v0[1]); w.y = cvt_pk_bf16(v0[2], v0[3]); w.z = cvt_pk_bf16(v1[0], v1[1]); w.w = cvt_pk_bf16(v1[2], v1[3]); *(u32x4*)(hb + off) = w; }
                }
                q += __shfl_xor(q, 16); q += __shfl_xor(q, 32);
                if (fq == 0) ss[(size_t)row * 16 + u.pn * 4 + wc] = q;
            }
            asm volatile("" ::: "memory");
        }
    }
};
struct EpiWin {
    static constexpr bool PERM = true, AFTER_DRAIN = false;
    bf16_t* p; bf16_t* ux; bf16_t* sg; const float* ss;
    __device__ __forceinline__ void operator()(AccRef acc, const Unit& u, int wr, int wc, int fr, int fq) const {
        const int row0 = u.pm * BM + wr * 64 + fr, tc0 = wc * 32 + 8 * fq;
        float rr[2][4]; load_rstd8(ss, row0, fq, rr);
#pragma unroll
        for (int ai = 0; ai < 2; ++ai)
#pragma unroll
            for (int m = 0; m < 4; ++m) {
                const int row = row0 + ai * HALF + m * 16; const float r = rr[ai][m];
#pragma unroll
                for (int bj = 0; bj < 2; ++bj) {
                    const int tc = tc0 + bj * HALF;
                    f32x4 v0 = acc[ai][bj][m][0] * r, v1 = acc[ai][bj][m][1] * r;
                    bf16_t* dst;
                    if (u.pn < 2) dst = p + (size_t)row * DPOOL + u.pn * BM + tc;
                    else if (u.pn == 2) { const int gi = tc >> 4, h0 = tc & 15; dst = ux + ((size_t)(gi * NCH + (row >> 6))) * UXLD + (row & 63) * 16 + h0; }
                    else {
                        dst = sg + (size_t)row * 2048 + (u.pn - 3) * BM + tc;
#pragma unroll
                        for (int j = 0; j < 4; ++j) { v0[j] = sigmoid_f(v0[j]); v1[j] = sigmoid_f(v1[j]); }
                    }
                    u32x4 w; w.x = cvt_pk_bf16(v0[0], v0[1]); w.y = cvt_pk_bf16(v0[2], v0[3]); w.z = cvt_pk_bf16(v1[0], v1[1]); w.w = cvt_pk_bf16(v1[2], v1[3]);
                    *(u32x4*)dst = w;
                }
            }
    }
};
struct EpiPool {
    static constexpr bool PERM = true, AFTER_DRAIN = false;
    bf16_t* zp; const bf16_t* sg;
    __device__ __forceinline__ void operator()(AccRef acc, const Unit& u, int wr, int wc, int fr, int fq) const {
        const int row0 = u.pm * BM + wr * 64 + fr, col0 = u.pn * BM + wc * 32 + 8 * fq;
#pragma unroll
        for (int ai = 0; ai < 2; ++ai) {
            u32x4 sv[4][2];
#pragma unroll
            for (int m = 0; m < 4; ++m)
#pragma unroll
                for (int bj = 0; bj < 2; ++bj) sv[m][bj] = *(const u32x4*)(sg + (size_t)(row0 + ai * HALF + m * 16) * 2048 + col0 + bj * HALF);
#pragma unroll
            for (int m = 0; m < 4; ++m)
#pragma unroll
                for (int bj = 0; bj < 2; ++bj) {
                    const u32x4 t = sv[m][bj]; const f32x4 a0 = acc[ai][bj][m][0], a1 = acc[ai][bj][m][1];
                    u32x4 w; w.x = cvt_pk_bf16(a0[0] * bf_lo(t.x), a0[1] * bf_hi(t.x)); w.y = cvt_pk_bf16(a0[2] * bf_lo(t.y), a0[3] * bf_hi(t.y));
                    w.z = cvt_pk_bf16(a1[0] * bf_lo(t.z), a1[1] * bf_hi(t.z)); w.w = cvt_pk_bf16(a1[2] * bf_lo(t.w), a1[3] * bf_hi(t.w));
                    *(u32x4*)(zp + (size_t)(row0 + ai * HALF + m * 16) * DM + col0 + bj * HALF) = w;
                }
            asm volatile("" ::: "memory");
        }
    }
};
struct EpiGLU {
    static constexpr bool PERM = true, AFTER_DRAIN = false;
    bf16_t* merged; const bf16_t* zp; const bf16_t* sg;
    __device__ __forceinline__ void operator()(AccRef acc, const Unit& u, int wr, int wc, int fr, int fq) const {
        const int row0 = u.pm * BM + wr * 64 + fr, col = u.pn * 128 + wc * 32 + 8 * fq;
#pragma unroll
        for (int ai = 0; ai < 2; ++ai) {
            u32x4 zv[4], sv[4];
#pragma unroll
            for (int m = 0; m < 4; ++m) { const int row = row0 + ai * HALF + m * 16; zv[m] = *(const u32x4*)(zp + (size_t)row * DM + col); sv[m] = *(const u32x4*)(sg + (size_t)row * 2048 + 1024 + col); }
#pragma unroll
            for (int m = 0; m < 4; ++m) {
                const int row = row0 + ai * HALF + m * 16; const u32x4 z = zv[m], t = sv[m];
                float o[8];
#pragma unroll
                for (int n = 0; n < 2; ++n)
#pragma unroll
                    for (int j = 0; j < 4; ++j) o[n * 4 + j] = acc[ai][0][m][n][j] * sigmoid_f(acc[ai][1][m][n][j]);
                u32x4 w;
                w.x = cvt_pk_bf16(bf_lo(z.x) + bf_lo(t.x) * o[0], bf_hi(z.x) + bf_hi(t.x) * o[1]);
                w.y = cvt_pk_bf16(bf_lo(z.y) + bf_lo(t.y) * o[2], bf_hi(z.y) + bf_hi(t.y) * o[3]);
                w.z = cvt_pk_bf16(bf_lo(z.z) + bf_lo(t.z) * o[4], bf_hi(z.z) + bf_hi(t.z) * o[5]);
                w.w = cvt_pk_bf16(bf_lo(z.w) + bf_lo(t.w) * o[6], bf_hi(z.w) + bf_hi(t.w) * o[7]);
                *(u32x4*)(merged + (size_t)row * DM + col) = w;
            }
            asm volatile("" ::: "memory");
        }
    }
};
template <bool HAS_SS> struct EpiBf16 {
    static constexpr bool PERM = true, AFTER_DRAIN = false;
    bf16_t* out; int ld, rowpn, colpn, colza; const float* ss; float scale;
    __device__ __forceinline__ void operator()(AccRef acc, const Unit& u, int wr, int wc, int fr, int fq) const {
        const int row0 = u.pm * BM + wr * 64 + fr + u.pn * rowpn, col0 = u.pn * colpn + u.za * colza + wc * 32 + 8 * fq;
        bf16_t* ob = out + (size_t)row0 * ld + col0;
        float rr[2][4];
        if (HAS_SS) load_rstd8(ss, u.pm * BM + wr * 64 + fr, fq, rr);
#pragma unroll
        for (int ai = 0; ai < 2; ++ai)
#pragma unroll
            for (int m = 0; m < 4; ++m) {
                float r = scale;
                if (HAS_SS) r *= rr[ai][m];
#pragma unroll
                for (int bj = 0; bj < 2; ++bj) {
                    const f32x4 v0 = acc[ai][bj][m][0] * r, v1 = acc[ai][bj][m][1] * r;
                    u32x4 w; w.x = cvt_pk_bf16(v0[0], v0[1]); w.y = cvt_pk_bf16(v0[2], v0[3]); w.z = cvt_pk_bf16(v1[0], v1[1]); w.w = cvt_pk_bf16(v1[2], v1[3]);
                    *(u32x4*)(ob + (size_t)(ai * HALF + m * 16) * ld + bj * HALF) = w;
                }
            }
    }
};
struct EpiStatesScan {
    static constexpr bool PERM = false, AFTER_DRAIN = true;
    bf16_t* ux; const f32x2* pw;
    __device__ __forceinline__ void fused(f32x4 (&acc)[2][2][4][2], const Unit& u, int wr, int wc, int fr, int fq, LAS unsigned char* lds, int wid, int lane) const {
        LAS float* T = (LAS float*)lds;
        const int tid = threadIdx.x;
#pragma unroll
        for (int half = 0; half < 2; ++half) {
#pragma unroll
            for (int ai = 0; ai < 2; ++ai)
#pragma unroll
                for (int m = 0; m < 4; ++m)
#pragma unroll
                    for (int n = 0; n < 2; ++n) *(LAS f32x4*)(T + (ai * HALF + wr * 64 + m * 16 + fr) * 132 + wc * 32 + n * 16 + 4 * fq) = acc[ai][half][m][n];
            __syncthreads();
            if (tid < 256) {
                const int b = tid >> 6, p = tid & 63;
                const f32x2 lam = pw[((half * 16 + u.za) * 64 + p) * 65 + 64];
                float xr = 0.f, xi = 0.f;
                bf16_t* ob = ux + ((size_t)(u.za * NCH + u.pm * BM + b * 64)) * UXLD + 1024 + half * 128 + p;
#pragma unroll 2
                for (int cc = 0; cc < 64; ++cc) {
                    const int c = half == 0 ? cc : 63 - cc;
                    const float sr = T[(b * 64 + c) * 132 + p], si = T[(b * 64 + c) * 132 + 64 + p];
                    ob[(size_t)c * UXLD] = (bf16_t)(cvt_pk_bf16(xr, 0.f) & 0xffffu); ob[(size_t)c * UXLD + 64] = (bf16_t)(cvt_pk_bf16(xi, 0.f) & 0xffffu);
                    const float nr = lam.x * xr - lam.y * xi + sr, ni = lam.x * xi + lam.y * xr + si; xr = nr; xi = ni;
                }
            }
            __syncthreads();
        }
    }
};
struct EpiSsmY {
    static constexpr bool PERM = true, AFTER_DRAIN = false;
    bf16_t* yact;
    __device__ __forceinline__ void operator()(AccRef acc, const Unit& u, int wr, int wc, int fr, int fq) const {
        const int row0 = u.pm * BM + wr * 64 + fr, c0 = u.pn * BM + wc * 32 + 8 * fq;
#pragma unroll
        for (int ai = 0; ai < 2; ++ai)
#pragma unroll
            for (int m = 0; m < 4; ++m) {
                const int row = row0 + ai * HALF + m * 16;
#pragma unroll
                for (int bj = 0; bj < 2; ++bj) {
                    const int c = c0 + bj * HALF, t = c >> 4, h0 = c & 15;
                    const f32x4 a0 = acc[ai][bj][m][0], a1 = acc[ai][bj][m][1];
                    u32x4 w; w.x = cvt_pk_bf16(gelu_tanh_f(a0[0]), gelu_tanh_f(a0[1])); w.y = cvt_pk_bf16(gelu_tanh_f(a0[2]), gelu_tanh_f(a0[3]));
                    w.z = cvt_pk_bf16(gelu_tanh_f(a1[0]), gelu_tanh_f(a1[1])); w.w = cvt_pk_bf16(gelu_tanh_f(a1[2]), gelu_tanh_f(a1[3]));
                    *(u32x4*)(yact + ((size_t)row * CH + t) * DSSM + u.za * 16 + h0) = w;
                }
            }
    }
};
struct EpiSoftmax {
    static constexpr bool PERM = true, AFTER_DRAIN = true;
    bf16_t* P;
    __device__ __forceinline__ void fused(f32x4 (&acc)[2][2][4][2], const Unit& u, int wr, int wc, int fr, int fq, LAS unsigned char* lds, int wid, int lane) const {
        LAS float* red = (LAS float*)lds; LAS float* red2 = (LAS float*)(lds + 4096);
#pragma unroll
        for (int ai = 0; ai < 2; ++ai)
#pragma unroll
            for (int m = 0; m < 4; ++m) {
                float mx = -3.0e38f;
#pragma unroll
                for (int bj = 0; bj < 2; ++bj)
#pragma unroll
                    for (int n = 0; n < 2; ++n)
#pragma unroll
                        for (int j = 0; j < 4; ++j) mx = fmaxf(mx, acc[ai][bj][m][n][j]);
                mx = fmaxf(mx, __shfl_xor(mx, 16)); mx = fmaxf(mx, __shfl_xor(mx, 32));
                if (fq == 0) red[(ai * HALF + wr * 64 + m * 16 + fr) * 4 + wc] = mx;
            }
        __syncthreads();
#pragma unroll
        for (int ai = 0; ai < 2; ++ai)
#pragma unroll
            for (int m = 0; m < 4; ++m) {
                const int r = ai * HALF + wr * 64 + m * 16 + fr;
                const f32x4 q = *(const LAS f32x4*)(red + r * 4);
                const float mx = fmaxf(fmaxf(q[0], q[1]), fmaxf(q[2], q[3])) * 1.4426950408889634f; float s = 0.f;
#pragma unroll
                for (int bj = 0; bj < 2; ++bj)
#pragma unroll
                    for (int n = 0; n < 2; ++n)
#pragma unroll
                        for (int j = 0; j < 4; ++j) { const float e = __builtin_amdgcn_exp2f(acc[ai][bj][m][n][j] * 1.4426950408889634f - mx); acc[ai][bj][m][n][j] = e; s += e; }
                s += __shfl_xor(s, 16); s += __shfl_xor(s, 32);
                if (fq == 0) red2[r * 4 + wc] = s;
            }
        __syncthreads();
#pragma unroll
        for (int ai = 0; ai < 2; ++ai)
#pragma unroll
            for (int m = 0; m < 4; ++m) {
                const int r = ai * HALF + wr * 64 + m * 16 + fr;
                const f32x4 q = *(const LAS f32x4*)(red2 + r * 4);
                const float inv = 1.0f / ((q[0] + q[1]) + (q[2] + q[3]));
#pragma unroll
                for (int bj = 0; bj < 2; ++bj) {
                    const f32x4 v0 = acc[ai][bj][m][0] * inv, v1 = acc[ai][bj][m][1] * inv;
                    u32x4 w; w.x = cvt_pk_bf16(v0[0], v0[1]); w.y = cvt_pk_bf16(v0[2], v0[3]); w.z = cvt_pk_bf16(v1[0], v1[1]); w.w = cvt_pk_bf16(v1[2], v1[3]);
                    *(u32x4*)(P + (size_t)(u.pm * BM + r) * DM + u.za * 256 + bj * HALF + wc * 32 + 8 * fq) = w;
                }
            }
        __syncthreads();
    }
};
}

struct TrDesc { const float* W; bf16_t* WT; const float* gk; int N, ldo, orow, k0, n0; };
__device__ __forceinline__ void tr_load(const TrDesc& d, f32x4 (&v)[8], int lane) {
    const int kr = lane >> 3, n4 = (lane & 7) * 4;
#pragma unroll
    for (int i = 0; i < 8; ++i) v[i] = *(const f32x4*)(d.W + (size_t)(d.k0 + i * 8 + kr) * d.N + d.n0 + n4);
    if (d.gk) {
#pragma unroll
        for (int i = 0; i < 8; ++i) v[i] = v[i] * d.gk[d.k0 + i * 8 + kr];
    }
}
__device__ __forceinline__ void tr_store(const TrDesc& d, const f32x4 (&v)[8], LAS float* scr, int lane) {
    const int kr = lane >> 3, n4 = (lane & 7) * 4;
#pragma unroll
    for (int i = 0; i < 8; ++i) { LAS float* q = scr + (i * 8 + kr) * 33 + n4; q[0] = v[i].x; q[1] = v[i].y; q[2] = v[i].z; q[3] = v[i].w; }
    LDS_WAIT();
    const int c = lane & 7;
#pragma unroll
    for (int j = 0; j < 4; ++j) { const int n = (lane >> 3) + 8 * j; const LAS float* t = scr + (8 * c) * 33 + n;
        u32x4 o; o.x = cvt_pk_bf16(t[0 * 33], t[1 * 33]); o.y = cvt_pk_bf16(t[2 * 33], t[3 * 33]); o.z = cvt_pk_bf16(t[4 * 33], t[5 * 33]); o.w = cvt_pk_bf16(t[6 * 33], t[7 * 33]);
        *(u32x4*)(d.WT + (size_t)(d.orow + n) * d.ldo + d.k0 + 8 * c) = o; }
    LDS_WAIT();
}
__device__ __forceinline__ u32x4 opq(u32x4 v) { asm volatile("" : "+v"(v)); return v; }
template <int GI> __device__ __forceinline__ void pool_strip(const bf16_t* pbuf, bf16_t* pooled, int row0, int t0, int ch0) {
    constexpr int W = 2 << GI, LEFT = W / 2, RIGHT = W - 1 - LEFT, NR = 16 + W - 1;
    u32x4 rows[NR];
    const bf16_t* base = pbuf + (size_t)row0 * DPOOL + ch0;
#pragma unroll
    for (int r = 0; r < NR; ++r) { const int t = t0 + r - LEFT; rows[r] = (t >= 0 && t < SEQL) ? *(const u32x4*)(base + (ptrdiff_t)(r - LEFT) * DPOOL) : (u32x4){0u, 0u, 0u, 0u}; }
    float S[8];
#pragma unroll
    for (int e = 0; e < 8; ++e) S[e] = 0.f;
#pragma unroll
    for (int r = 0; r < W; ++r) { const u32x4 v = opq(rows[r]); S[0] += bf_lo(v.x); S[1] += bf_hi(v.x); S[2] += bf_lo(v.y); S[3] += bf_hi(v.y); S[4] += bf_lo(v.z); S[5] += bf_hi(v.z); S[6] += bf_lo(v.w); S[7] += bf_hi(v.w); }
#pragma unroll
    for (int i = 0; i < 16; ++i) {
        const int t = t0 + i; const int lo = max(t - LEFT, 0), hi = min(t + RIGHT + 1, SEQL); const float inv = 1.0f / (float)(hi - lo);
        const u32x4 sv = opq(rows[i + LEFT]);
        u32x4 o; o.x = cvt_pk_bf16(S[0] * inv - bf_lo(sv.x), S[1] * inv - bf_hi(sv.x)); o.y = cvt_pk_bf16(S[2] * inv - bf_lo(sv.y), S[3] * inv - bf_hi(sv.y));
        o.z = cvt_pk_bf16(S[4] * inv - bf_lo(sv.z), S[5] * inv - bf_hi(sv.z)); o.w = cvt_pk_bf16(S[6] * inv - bf_lo(sv.w), S[7] * inv - bf_hi(sv.w));
        *(u32x4*)(pooled + (size_t)(row0 + i) * DPOOL + ch0) = o;
        if (i < 15) { const u32x4 a = opq(rows[i + W]), b = opq(rows[i]);
            S[0] += bf_lo(a.x) - bf_lo(b.x); S[1] += bf_hi(a.x) - bf_hi(b.x); S[2] += bf_lo(a.y) - bf_lo(b.y); S[3] += bf_hi(a.y) - bf_hi(b.y);
            S[4] += bf_lo(a.z) - bf_lo(b.z); S[5] += bf_hi(a.z) - bf_hi(b.z); S[6] += bf_lo(a.w) - bf_lo(b.w); S[7] += bf_hi(a.w) - bf_hi(b.w); }
    }
}

#define XB_TMO      128
#define XB_XCNT(j)  (256  + 64 * (j))
#define XB_XSUB(j)  (1280 + 64 * (j))
#define XB_XGEN(j)  (2304 + 64 * (j))
#define XB_TOP      3328
#define XB_TOPGEN   3392
#define XCD_BAR_WORDS 3456
#define XB_SPIN_CAP (1u << 22)
__device__ __forceinline__ unsigned xb_ld(unsigned* p)              { return __hip_atomic_load(p, __ATOMIC_RELAXED, __HIP_MEMORY_SCOPE_AGENT); }
__device__ __forceinline__ unsigned xb_add(unsigned* p, unsigned v) { return __hip_atomic_fetch_add(p, v, __ATOMIC_RELAXED, __HIP_MEMORY_SCOPE_AGENT); }
__device__ __forceinline__ unsigned xb_xcc_id() { return (unsigned)__builtin_amdgcn_s_getreg((3 << 11) | 20) & 0xFu; }
#define XB_SPIN(cond, bar) do { unsigned _sp = 0; while (cond) { __builtin_amdgcn_s_sleep(1); \
    if ((++_sp & 255u) == 0u) { if (xb_ld(&(bar)[XB_TMO])) break; if (_sp > XB_SPIN_CAP) { atomicAdd(&(bar)[XB_TMO], 1u); break; } } } } while (0)
struct XcdBarrier { unsigned* bar; unsigned x; volatile LAS unsigned* st; };
__device__ __forceinline__ XcdBarrier xcd_barrier_post(unsigned* bar, volatile LAS unsigned* st) {
    XcdBarrier b; b.bar = bar; b.x = xb_xcc_id(); b.st = st;
    if (threadIdx.x == 0) (void)xb_add(&bar[XB_XCNT(b.x)], 1u);
    return b;
}
__device__ __forceinline__ void xcd_barrier_complete(unsigned* bar, unsigned x, unsigned& nloc, unsigned& nx) {
    const unsigned G = gridDim.x * gridDim.y * gridDim.z;
    unsigned sum, cnt, mine, sp = 0u;
    for (;;) {
        sum = 0u; cnt = 0u; mine = 0u;
#pragma unroll
        for (unsigned j = 0; j < 16; ++j) { const unsigned c = xb_ld(&bar[XB_XCNT(j)]); sum += c; cnt += (c > 0u) ? 1u : 0u; mine = (j == x) ? c : mine; }
        if (sum == G) break;
        __builtin_amdgcn_s_sleep(1);
        if ((++sp & 255u) == 0u) { if (xb_ld(&bar[XB_TMO])) break; if (sp > XB_SPIN_CAP) { atomicAdd(&bar[XB_TMO], 1u); break; } }
    }
    nloc = mine > 0u ? mine : 1u; nx = cnt > 0u ? cnt : 1u;
}
__device__ __forceinline__ void xcd_barrier(const XcdBarrier& b) {
    asm volatile("s_waitcnt vmcnt(0)" ::: "memory");
    __syncthreads();
    if (threadIdx.x == 0) {
        unsigned* bar = b.bar;
        __builtin_amdgcn_s_waitcnt(0);
        unsigned nloc = b.st[0], nx = b.st[1];
        if (nloc == 0u) { xcd_barrier_complete(bar, b.x, nloc, nx); b.st[0] = nloc; b.st[1] = nx; }
        const unsigned old = xb_add(&bar[XB_XSUB(b.x)], 1u);
        const unsigned gen = old / nloc;
        if (old + 1u == (gen + 1u) * nloc) {
            __builtin_amdgcn_fence(__ATOMIC_RELEASE, "agent");
            asm volatile("s_waitcnt vmcnt(0)" ::: "memory");
            const unsigned og = xb_add(&bar[XB_TOP], 1u);
            const unsigned tg = og / nx;
            if (og + 1u == (tg + 1u) * nx) xb_add(&bar[XB_TOPGEN], 1u);
            else XB_SPIN(xb_ld(&bar[XB_TOPGEN]) == tg, bar);
            __builtin_amdgcn_fence(__ATOMIC_ACQUIRE, "agent");
            xb_add(&bar[XB_XGEN(b.x)], 1u);
            asm volatile("s_waitcnt vmcnt(0)" ::: "memory");
        } else {
            XB_SPIN(xb_ld(&bar[XB_XGEN(b.x)]) == gen, bar);
            __builtin_amdgcn_fence(__ATOMIC_ACQUIRE, "agent");
            asm volatile("s_waitcnt vmcnt(0)" ::: "memory");
        }
    }
    __syncthreads();
}

struct Args { const float* in[32]; float* out; unsigned char* ws; int ph_lo, ph_hi; };
constexpr int NPHASE = 16;
__device__ __forceinline__ const float* ARGP(int i) {
    const __attribute__((address_space(4))) char* kp = (const __attribute__((address_space(4))) char*)__builtin_amdgcn_kernarg_segment_ptr();
    int off = i * 8; asm volatile("" : "+s"(off));
    return *(const float* const __attribute__((address_space(4)))*)(kp + off);
}

__global__ void __launch_bounds__(512, 2) mk_fwd(Args a) {
    extern __shared__ __attribute__((aligned(16))) unsigned char lds_raw[];
    LAS unsigned char* lds = (LAS unsigned char*)lds_raw;
    cg::grid_group grid = cg::this_grid();
    const int tid = threadIdx.x, lane = tid & 63, wave = __builtin_amdgcn_readfirstlane(tid >> 6);
    const int G = gridDim.x, bx = blockIdx.x;
    const int gtid = bx * 512 + tid, NT = G * 512, gw = bx * 8 + wave, NGW = G * 8;
    unsigned char* ws = a.ws;
    float* ss0 = (float*)(ws + WS_SS); float* ss1 = ss0 + (size_t)MTOK * 16; float* ss2 = ss1 + (size_t)MTOK * 16; float* ss3 = ss2 + (size_t)MTOK * 16; float* ss4 = ss3 + (size_t)MTOK * 16;
    f32x2* pw = (f32x2*)(ws + WS_PW); f32x2* bbar = (f32x2*)(ws + WS_BBAR); float* kt = (float*)(ws + WS_KT);
    bf16_t* w1gu = (bf16_t*)(ws + WS_W1GU); bf16_t* w1d = (bf16_t*)(ws + WS_W1D); bf16_t* w2gu = (bf16_t*)(ws + WS_W2GU); bf16_t* w2d = (bf16_t*)(ws + WS_W2D);
    bf16_t* win = (bf16_t*)(ws + WS_WIN); bf16_t* wpe = (bf16_t*)(ws + WS_WPE); bf16_t* wglu = (bf16_t*)(ws + WS_WGLU); bf16_t* wmo = (bf16_t*)(ws + WS_WMO);
    bf16_t* wq = (bf16_t*)(ws + WS_WQ); bf16_t* wkv = (bf16_t*)(ws + WS_WKV); bf16_t* wxo = (bf16_t*)(ws + WS_WXO);
    bf16_t* sE = (bf16_t*)(ws + WS_SE); bf16_t* sY = (bf16_t*)(ws + WS_SY);
    bf16_t* memn = (bf16_t*)(ws + WS_MEMN); bf16_t* kb = (bf16_t*)(ws + WS_KB); bf16_t* vT = (bf16_t*)(ws + WS_VT);
    bf16_t* r1 = (bf16_t*)(ws + WS_R1);
    bf16_t* Hb = (bf16_t*)(ws + WS_HB);
    bf16_t* sg = Hb; bf16_t* pbuf = (bf16_t*)(ws + WS_HB + 128 * MiB);
    bf16_t* qb = Hb; bf16_t* Pb = (bf16_t*)(ws + WS_HB + 64 * MiB);
    bf16_t* pooled = (bf16_t*)(ws + WS_R2); bf16_t* yact = (bf16_t*)(ws + WS_R2 + 32 * MiB); float* states = (float*)(ws + WS_R2 + 48 * MiB); bf16_t* ux = (bf16_t*)(ws + WS_R2 + 56 * MiB);
    bf16_t* r3 = (bf16_t*)(ws + WS_R3);
    float* hout = a.out;
#ifndef USE_XCD_BAR
#define USE_XCD_BAR 1
#endif
#if USE_XCD_BAR
    volatile LAS unsigned* bst = (volatile LAS unsigned*)(lds + 147456 - 1024);
    if (tid < 2) bst[tid] = 0u;
    __syncthreads();
    XcdBarrier xbar = xcd_barrier_post((unsigned*)(ws + WS_CTL), bst);
#define GRID_BAR(k) do { if ((k) == 0) grid.sync(); else xcd_barrier(xbar); } while (0)
#else
#define GRID_BAR(k) grid.sync()
#endif

#ifndef PHMASK
#define PHMASK 0xffff
#endif
#ifndef PROBE_MODE
#define PROBE_MODE 0
#endif
#ifndef PROBE_MUL
#define PROBE_MUL 1
#endif
#ifndef PROBE_A
#define PROBE_A 0
#endif
#ifndef PROBE_B
#define PROBE_B 1
#endif
#if PROBE_MODE
    volatile LAS unsigned long long* marks = (volatile LAS unsigned long long*)(lds + 147456 - 512);
#define MARK(i) do { if (tid == 0) marks[i] = __builtin_amdgcn_s_memrealtime(); } while (0)
#else
#define MARK(i) do { } while (0)
#endif
    MARK(0);
#define IN(k) (((PHMASK >> (k)) & 1) && a.ph_lo <= (k) && (k) < a.ph_hi)
#define SEAM(k) do { MARK(1 + 2 * (k)); if (IN(k) && IN((k) + ((k) == 5 ? 2 : 1))) GRID_BAR(k); MARK(2 + 2 * (k)); } while (0)

    if (IN(0)) {
        LAS float* scr = (LAS float*)(lds + wave * 18432);
        constexpr int I_FF = (DM / 64) * (FF / 32), I_FD = (FF / 64) * (DM / 32), I_GL = (DSSM / 64) * (DM / 32), I_SQ = (DM / 64) * (DM / 32), I_KV = (DM / 64) * (2048 / 32);
        constexpr int NITEMS = 4 * I_FF + 2 * I_FD + I_FF + 2 * I_GL + 3 * I_SQ + I_KV;
#define TR(SRC, KK, NN, DST, MODE, GK) if (!done_) { constexpr int items_ = ((KK) / 64) * ((NN) / 32); if (r < items_) { const int nblk = (NN) / 32, kb_ = r / nblk, nb_ = r % nblk, n0 = nb_ * 32; \
            d.W = SRC; d.WT = DST; d.gk = GK; d.N = NN; d.ldo = KK; d.orow = (MODE) == 0 ? n0 : (((n0 >> 7) << 8) + (n0 & 127) + ((MODE) == 2 ? 128 : 0)); d.k0 = kb_ * 64; d.n0 = n0; done_ = true; } else r -= items_; }
#define DECODE(IT, D) { TrDesc d; int r = (IT); bool done_ = false; \
            TR(ARGP(3), DM, FF, w1gu, 1, ARGP(2)) TR(ARGP(4), DM, FF, w1gu, 2, ARGP(2)) TR(ARGP(5), FF, DM, w1d, 0, nullptr) \
            TR(ARGP(28), DM, FF, w2gu, 1, ARGP(27)) TR(ARGP(29), DM, FF, w2gu, 2, ARGP(27)) TR(ARGP(30), FF, DM, w2d, 0, nullptr) \
            TR(ARGP(7), DM, DIN, win, 0, ARGP(6)) \
            TR(ARGP(19), DSSM, DM, wglu, 1, nullptr) TR(ARGP(20), DSSM, DM, wglu, 2, nullptr) \
            TR(ARGP(21), DM, DM, wmo, 0, nullptr) TR(ARGP(24), DM, DM, wq, 0, ARGP(22)) TR(ARGP(26), DM, DM, wxo, 0, nullptr) \
            TR(ARGP(25), DM, 2048, wkv, 0, nullptr) D = d; }
        for (int it = gw; it < NITEMS; it += 2 * NGW) {
            const bool has1 = it + NGW < NITEMS;
            TrDesc d0, d1; DECODE(it, d0) DECODE(has1 ? it + NGW : it, d1)
            f32x4 v0[8], v1[8];
            tr_load(d0, v0, lane); tr_load(d1, v1, lane);
            tr_store(d0, v0, scr, lane);
            if (has1) tr_store(d1, v1, scr + 64 * 33, lane);
        }
#undef TR
#undef DECODE
        for (int mrow = gw; mrow < MTOK; mrow += 2 * NGW) {
            const int rowb = (mrow + NGW < MTOK) ? mrow + NGW : mrow;
            const f32x4* xa = (const f32x4*)(ARGP(0) + (size_t)mrow * DM) + lane; const f32x4* xb_ = (const f32x4*)(ARGP(0) + (size_t)rowb * DM) + lane;
            f32x4 va[4], vb[4]; float sa = 0.f, sb = 0.f;
#pragma unroll
            for (int j = 0; j < 4; ++j) { va[j] = xa[64 * j]; vb[j] = xb_[64 * j]; }
#pragma unroll
            for (int j = 0; j < 4; ++j) { sa += (va[j].x * va[j].x + va[j].y * va[j].y) + (va[j].z * va[j].z + va[j].w * va[j].w); sb += (vb[j].x * vb[j].x + vb[j].y * vb[j].y) + (vb[j].z * vb[j].z + vb[j].w * vb[j].w); }
            sa = wave_sum(sa); sb = wave_sum(sb);
            u32x2* oa = (u32x2*)(r1 + (size_t)mrow * DM) + lane; u32x2* ob = (u32x2*)(r1 + (size_t)rowb * DM) + lane;
#pragma unroll
            for (int j = 0; j < 4; ++j) { u32x2 w; w.x = cvt_pk_bf16(va[j].x, va[j].y); w.y = cvt_pk_bf16(va[j].z, va[j].w); oa[64 * j] = w; w.x = cvt_pk_bf16(vb[j].x, vb[j].y); w.y = cvt_pk_bf16(vb[j].z, vb[j].w); ob[64 * j] = w; }
            if (lane < 16) { ss0[(size_t)mrow * 16 + lane] = lane == 0 ? sa : 0.f; ss0[(size_t)rowb * 16 + lane] = lane == 0 ? sb : 0.f; }
        }
        for (int row = gw; row < MEMROWS; row += NGW) {
            const f32x4* xr = (const f32x4*)(ARGP(1) + (size_t)row * DM) + lane;
            f32x4 v[4]; float s = 0.f;
#pragma unroll
            for (int j = 0; j < 4; ++j) { v[j] = xr[64 * j]; s += (v[j].x * v[j].x + v[j].y * v[j].y) + (v[j].z * v[j].z + v[j].w * v[j].w); }
            s = wave_sum(s);
            u32x2* o8 = (u32x2*)(memn + (size_t)row * DM) + lane;
            const float rs = rsqrtf(s * (1.0f / 1024.0f) + EPS); const f32x4* gr = (const f32x4*)ARGP(23) + lane;
#pragma unroll
            for (int j = 0; j < 4; ++j) { const f32x4 gg = gr[64 * j]; u32x2 w; w.x = cvt_pk_bf16(v[j].x * rs * gg.x, v[j].y * rs * gg.y); w.y = cvt_pk_bf16(v[j].z * rs * gg.z, v[j].w * rs * gg.w); o8[64 * j] = w; }
        }
        if (gtid < 2048) {
            const int idx = gtid, dg = idx >> 6;
            const float dt = expf(ARGP(13)[dg]);
            const float ar = ARGP(11)[idx], ai = ARGP(12)[idx];
            const float mag = expf(dt * ar), ang = dt * ai;
            const float abr = mag * cosf(ang), abi = mag * sinf(ang);
            const float den = ar * ar + ai * ai, nr = abr - 1.0f;
            const float qr = (nr * ar + abi * ai) / den, qi = (abi * ar - nr * ai) / den;
            for (int h = 0; h < 16; ++h) { const float br = ARGP(14)[idx * 16 + h], bi = ARGP(15)[idx * 16 + h]; bbar[idx * 16 + h] = (f32x2){qr * br - qi * bi, qr * bi + qi * br}; }
            double pr = 1.0, pi = 0.0; const double dr = (double)abr, di = (double)abi;
            for (int t = 0; t <= 64; ++t) { pw[idx * 65 + t] = (f32x2){(float)pr, (float)pi}; const double nr2 = pr * dr - pi * di, ni2 = pr * di + pi * dr; pr = nr2; pi = ni2; }
        }
    }
    SEAM(0);

    if (IN(1)) {
        {
            LAS float* Cs = (LAS float*)lds; LAS float* Bs = Cs + 16 * 65 * 2; LAS float* Ps = Bs + 2048;
            for (int item = bx; item < 256; item += G) {
                const int dg = item >> 3, toct = item & 7;
                for (int i = tid; i < 1024; i += 512) { const int h = i >> 6, p = i & 63; Cs[(h * 65 + p) * 2] = ARGP(16)[dg * 1024 + i]; Cs[(h * 65 + p) * 2 + 1] = ARGP(17)[dg * 1024 + i];
                    const f32x2 b = bbar[dg * 1024 + i]; Bs[2 * i] = b.x; Bs[2 * i + 1] = b.y; }
                { const int p = tid >> 3, tl = tid & 7; const f32x2 w = pw[(dg * 64 + p) * 65 + toct * 8 + tl]; Ps[tid * 2] = w.x; Ps[tid * 2 + 1] = w.y; }
                __syncthreads();
                const int tl = tid >> 6, h = (tid >> 2) & 15, hq = tid & 3;
                float o0 = 0.f, o1 = 0.f, o2 = 0.f, o3 = 0.f;
#pragma unroll 4
                for (int p = 0; p < 64; ++p) {
                    const f32x2 c = *(const LAS f32x2*)(Cs + (h * 65 + p) * 2), w = *(const LAS f32x2*)(Ps + (p * 8 + tl) * 2);
                    const float cwr = c.x * w.x - c.y * w.y, cwi = c.x * w.y + c.y * w.x;
                    const f32x4 b01 = *(const LAS f32x4*)(Bs + (p * 16 + hq * 4) * 2), b23 = *(const LAS f32x4*)(Bs + (p * 16 + hq * 4 + 2) * 2);
                    o0 += cwr * b01.x - cwi * b01.y; o1 += cwr * b01.z - cwi * b01.w; o2 += cwr * b23.x - cwi * b23.y; o3 += cwr * b23.z - cwi * b23.w;
                }
                *(f32x4*)(kt + ((size_t)(dg * 64 + toct * 8 + tl)) * 256 + h * 16 + hq * 4) = (f32x4){o0, o1, o2, o3};
                __syncthreads();
            }
        }
        for (int idx = gtid; idx < 16 * 256 * 128; idx += NT) {
            const int k8 = idx & 127, j = (idx >> 7) & 255, g = idx >> 15;
            const int s = k8 >> 1, h0 = (k8 & 1) * 8, dd = j >> 7, part = (j >> 6) & 1, p = j & 63, dgp = ((dd * 16 + g) * 64 + p);
            const f32x2 w = pw[dgp * 65 + (dd == 0 ? 63 - s : s)];
            float o[8];
#pragma unroll
            for (int e = 0; e < 8; ++e) { const f32x2 b = bbar[dgp * 16 + h0 + e]; o[e] = part == 0 ? (w.x * b.x - w.y * b.y) : (w.x * b.y + w.y * b.x); }
            u32x4 v; v.x = cvt_pk_bf16(o[0], o[1]); v.y = cvt_pk_bf16(o[2], o[3]); v.z = cvt_pk_bf16(o[4], o[5]); v.w = cvt_pk_bf16(o[6], o[7]);
            *(u32x4*)(sE + ((size_t)(g * 256 + j)) * 1024 + k8 * 8) = v;
        }
        for (int idx = gtid; idx < 16 * 1024 * 32; idx += NT) {
            const int j8 = idx & 31, n = (idx >> 5) & 1023, g = idx >> 15;
            const int j0 = j8 * 8, dd = j0 >> 7, part = (j0 >> 6) & 1, p0 = j0 & 63, t = n >> 4, h = n & 15, tau = dd == 0 ? t + 1 : 64 - t;
            float o[8];
#pragma unroll
            for (int e = 0; e < 8; ++e) {
                const int p = p0 + e; const float cr = ARGP(16)[((dd * 16 + g) * 16 + h) * 64 + p], ci = ARGP(17)[((dd * 16 + g) * 16 + h) * 64 + p];
                const f32x2 w = pw[((dd * 16 + g) * 64 + p) * 65 + tau];
                o[e] = part == 0 ? (cr * w.x - ci * w.y) : -(cr * w.y + ci * w.x);
            }
            u32x4 v; v.x = cvt_pk_bf16(o[0], o[1]); v.y = cvt_pk_bf16(o[2], o[3]); v.z = cvt_pk_bf16(o[4], o[5]); v.w = cvt_pk_bf16(o[6], o[7]);
            *(u32x4*)(sY + ((size_t)(g * 1024 + n)) * UXLD + 1024 + j0) = v;
        }
        for (int idx = gtid; idx < 512 * 256; idx += NT) {
            const int n4 = (idx & 255) * 4, kc = idx >> 8, g = kc >> 7;
            const float* pwr = ARGP(8) + (size_t)kc * 128; const float* psc = ARGP(9) + g * 128; const float* wp = ARGP(10) + (size_t)(g * 128) * DM + n4;
            f32x4 sacc = (f32x4){0.f, 0.f, 0.f, 0.f};
#pragma unroll 16
            for (int d = 0; d < 128; ++d) sacc += *(const f32x4*)(wp + (size_t)d * DM) * (pwr[d] * psc[d]);
            wpe[(size_t)(n4 + 0) * DPOOL + kc] = (bf16_t)(cvt_pk_bf16(sacc.x, 0.f) & 0xffffu); wpe[(size_t)(n4 + 1) * DPOOL + kc] = (bf16_t)(cvt_pk_bf16(sacc.y, 0.f) & 0xffffu);
            wpe[(size_t)(n4 + 2) * DPOOL + kc] = (bf16_t)(cvt_pk_bf16(sacc.z, 0.f) & 0xffffu); wpe[(size_t)(n4 + 3) * DPOOL + kc] = (bf16_t)(cvt_pk_bf16(sacc.w, 0.f) & 0xffffu);
        }
        __syncthreads();
        MARK(40);
        pg8::Gemm g{r1, w1gu, DM, DM, DM, 0, 0}; pg8::StaticOrder S; S.init(MTOK, 2 * FF, G, bx);
        pg8::EpiSwiGLU E{Hb, ss0};
        pg8::gemm_phase<pg8::EpiSwiGLU, pg8::StaticOrder, true>(lds, g, S, E);
    }
    SEAM(1);

    if (IN(2)) {
        for (int idx = gtid; idx < 16 * 1024 * 128; idx += NT) {
            const int k8 = idx & 127, n = (idx >> 7) & 1023, g = idx >> 17;
            const int s = k8 >> 1, h0 = (k8 & 1) * 8, t = n >> 4, h = n & 15;
            float o[8];
#pragma unroll
            for (int e = 0; e < 8; ++e) {
                const int h2 = h0 + e; float v = 0.f;
                if (s <= t) v += kt[((0 * 16 + g) * 64 + (t - s)) * 256 + h * 16 + h2];
                if (s >= t) v += kt[((1 * 16 + g) * 64 + (s - t)) * 256 + h * 16 + h2];
                if (s == t && h == h2) v += ARGP(18)[g * 16 + h];
                o[e] = v;
            }
            u32x4 v; v.x = cvt_pk_bf16(o[0], o[1]); v.y = cvt_pk_bf16(o[2], o[3]); v.z = cvt_pk_bf16(o[4], o[5]); v.w = cvt_pk_bf16(o[6], o[7]);
            *(u32x4*)(sY + ((size_t)(g * 1024 + n)) * UXLD + k8 * 8) = v;
        }
        MARK(41);
        pg8::Gemm g{Hb, w1d, FF, FF, FF, 0, 0}; pg8::StaticOrder S; S.init(MTOK, DM, G, bx);
        pg8::EpiResid<true> E{ARGP(0), hout, r1, ss1, 0.5f};
        pg8::gemm_phase<pg8::EpiResid<true>, pg8::StaticOrder, true>(lds, g, S, E);
    }
    SEAM(2);

    if (IN(3)) {
        { pg8::Gemm g{r1, win, DM, DM, DM, 0, 0}; pg8::StaticOrder S; S.init(MTOK, DIN, G, bx);
          pg8::EpiWin E{pbuf, ux, sg, ss1};
          pg8::gemm_phase<pg8::EpiWin, pg8::StaticOrder, true>(lds, g, S, E); }
        {
          pg8::Gemm g{memn, wkv, DM, DM, DM, 0, 0}; pg8::StaticOrder S; S.init(MEMROWS, DM, 64, (bx >= 128 && bx < 192) ? bx - 128 : -1);
          pg8::EpiBf16<false> E{kb, DM, 0, 256, 0, nullptr, 1.0f};
          pg8::gemm_phase<pg8::EpiBf16<false>, pg8::StaticOrder, true>(lds, g, S, E); }
        {
          pg8::Gemm g{wkv + (size_t)DM * DM, memn, DM, DM, DM, 0, 0}; pg8::StaticOrder S; S.init(DM, MEMROWS, 64, (bx >= 192) ? bx - 192 : -1);
          pg8::EpiBf16<false> E{vT, 256, 1024, 0, 0, nullptr, 1.0f};
          pg8::gemm_phase<pg8::EpiBf16<false>, pg8::StaticOrder, true>(lds, g, S, E); }
    }
    SEAM(3);

    if (IN(4)) {
        const int nsb = G > 32 ? 32 : 0;
        if (bx < 32 || nsb == 0) {
            pg8::Gemm g{ux, sE, UXLD, 1024, 1024, (size_t)NCH * UXLD, (size_t)256 * 1024}; pg8::GenOrder<0> S{32, 2, 1, nsb ? 32 : G, bx};
            pg8::EpiStatesScan E{ux, pw};
            for (int i = 0;; ++i) {
                pg8::OneUnit O; O.valid = S.next(i, O.u); if (!O.valid) break;
                pg8::gemm_phase<pg8::EpiStatesScan, pg8::OneUnit, false>(lds, g, O, E);
            }
        }
        if (bx >= nsb) {
            const int wgl = (bx - nsb) * 8 + wave, nwg_ = (G - nsb) * 8;
            for (int item = wgl; item < (MTOK / 64) * 4; item += nwg_) {
                const int gi = item & 3, sg4 = item >> 2;
                const int row0 = sg4 * 64 + (lane >> 4) * 16, t0 = row0 & (SEQL - 1), ch0 = gi * 128 + (lane & 15) * 8;
                if (gi == 0) pool_strip<0>(pbuf, pooled, row0, t0, ch0);
                else if (gi == 1) pool_strip<1>(pbuf, pooled, row0, t0, ch0);
                else if (gi == 2) pool_strip<2>(pbuf, pooled, row0, t0, ch0);
                else pool_strip<3>(pbuf, pooled, row0, t0, ch0);
            }
        }
    }
    SEAM(4);

    if (IN(5)) {
        const bool split = (G == 256);
        { pg8::Gemm g{ux, sY, UXLD, UXLD, UXLD, (size_t)NCH * UXLD, (size_t)1024 * UXLD}; pg8::GenOrder<0> S{128, 2, 4, split ? 128 : G, split ? (bx < 128 ? bx : -1) : bx};
          pg8::EpiSsmY E{yact};
          pg8::gemm_phase<pg8::EpiSsmY, pg8::GenOrder<0>, true>(lds, g, S, E); }
        { pg8::Gemm g{pooled, wpe, DPOOL, DPOOL, DPOOL, 0, 0}; pg8::StaticOrder S;
          if (!split) S.init(MTOK, DM, G, bx);
          else if (bx >= 128) S.init(MTOK, DM, 128, bx - 128, 0, 3);
          else S.init(MTOK, DM, 128, bx, 384, 1);
          pg8::EpiPool E{r1, sg};
          pg8::gemm_phase<pg8::EpiPool, pg8::StaticOrder, true>(lds, g, S, E); }
    }
    SEAM(5);

    if (IN(7)) {
        pg8::Gemm g{yact, wglu, DSSM, DSSM, DSSM, 0, 0}; pg8::StaticOrder S; S.init(MTOK, 2048, G, bx);
        pg8::EpiGLU E{r3, r1, sg};
        pg8::gemm_phase<pg8::EpiGLU, pg8::StaticOrder, true>(lds, g, S, E);
    }
    SEAM(7);

    if (IN(8)) {
        pg8::Gemm g{r3, wmo, DM, DM, DM, 0, 0}; pg8::StaticOrder S; S.init(MTOK, DM, G, bx);
        pg8::EpiResid<true> E{hout, hout, r1, ss2, 1.0f};
        pg8::gemm_phase<pg8::EpiResid<true>, pg8::StaticOrder, true>(lds, g, S, E);
    }
    SEAM(8);

    if (IN(9)) {
        pg8::Gemm g{r1, wq, DM, DM, DM, 0, 0}; pg8::StaticOrder S; S.init(MTOK, DM, G, bx);
        pg8::EpiBf16<true> E{qb, DM, 0, 256, 0, ss2, 0.0625f};
        pg8::gemm_phase<pg8::EpiBf16<true>, pg8::StaticOrder, true>(lds, g, S, E);
    }
    SEAM(9);

    if (IN(10)) {
        pg8::Gemm g{qb, kb, DM, DM, 256, 256, 256}; pg8::GenOrder<1> S{512, 0, 0, G, bx};
        pg8::EpiSoftmax E{Pb};
        for (int i = 0;; ++i) {
            pg8::OneUnit O; O.valid = S.next(i, O.u); if (!O.valid) break;
            pg8::gemm_phase<pg8::EpiSoftmax, pg8::OneUnit, false>(lds, g, O, E);
        }
    }
    SEAM(10);

    if (IN(11)) {
        pg8::Gemm g{Pb, vT, DM, 256, 256, 256, 0}; pg8::GenOrder<2> S{512, 0, 0, G, bx};
        pg8::EpiBf16<false> E{r3, DM, 0, 0, 256, nullptr, 1.0f};
        pg8::gemm_phase<pg8::EpiBf16<false>, pg8::GenOrder<2>, true>(lds, g, S, E);
    }
    SEAM(11);

    if (IN(12)) {
        pg8::Gemm g{r3, wxo, DM, DM, DM, 0, 0}; pg8::StaticOrder S; S.init(MTOK, DM, G, bx);
        pg8::EpiResid<true> E{hout, hout, r1, ss3, 1.0f};
        pg8::gemm_phase<pg8::EpiResid<true>, pg8::StaticOrder, true>(lds, g, S, E);
    }
    SEAM(12);

    if (IN(13)) {
        pg8::Gemm g{r1, w2gu, DM, DM, DM, 0, 0}; pg8::StaticOrder S; S.init(MTOK, 2 * FF, G, bx);
        pg8::EpiSwiGLU E{Hb, ss3};
        pg8::gemm_phase<pg8::EpiSwiGLU, pg8::StaticOrder, true>(lds, g, S, E);
    }
    SEAM(13);

    if (IN(14)) {
        pg8::Gemm g{Hb, w2d, FF, FF, FF, 0, 0}; pg8::StaticOrder S; S.init(MTOK, DM, G, bx);
        pg8::EpiResid<false> E{hout, hout, nullptr, ss4, 0.5f};
        pg8::gemm_phase<pg8::EpiResid<false>, pg8::StaticOrder, true>(lds, g, S, E);
    }
    SEAM(14);

    if (IN(15)) {
        const f32x4* gr = (const f32x4*)ARGP(31) + lane;
        f32x4 gg[4];
#pragma unroll
        for (int j = 0; j < 4; ++j) gg[j] = gr[64 * j];
        for (int row = gw; row < MTOK; row += NGW) {
            const float rs = row_rstd(ss4, row);
            f32x4* xr = (f32x4*)(hout + (size_t)row * DM) + lane;
#pragma unroll
            for (int j = 0; j < 4; ++j) { f32x4 v = xr[64 * j]; v = v * rs * gg[j]; xr[64 * j] = v; }
        }
    }
    MARK(31);
#if PROBE_MODE
    __syncthreads();
    {
        unsigned long long span = 0;
#if PROBE_MODE == 1
        span = (marks[PROBE_B] - marks[PROBE_A]) * PROBE_MUL;
#else
        for (int k = 0; k < 15; ++k) span += marks[2 + 2 * k] - marks[1 + 2 * k];
#endif
        const unsigned long long t0 = marks[31];
        while (__builtin_amdgcn_s_memrealtime() - t0 < span) __builtin_amdgcn_s_sleep(8);
    }
#endif
#undef IN
#undef SEAM
}

constexpr int LDS_BYTES = 147456;

extern "C" void kernel_launch(void* const* d_in, const int* in_sizes, int n_in, void* d_out, int out_size, void* d_ws, size_t ws_size, hipStream_t stream) {
    static int grid = 0;
    if (grid == 0) {
        if (n_in != 32 || in_sizes[0] != MTOK * DM || out_size != MTOK * DM || ws_size < WS_END) { fprintf(stderr, "kernel_launch: unexpected shapes (n_in %d, ws %zu)\n", n_in, ws_size); grid = -1; return; }
        int dev = 0, cus = 0, per_cu = 0;
        hipGetDevice(&dev); hipDeviceGetAttribute(&cus, hipDeviceAttributeMultiprocessorCount, dev);
        hipFuncSetAttribute((const void*)mk_fwd, hipFuncAttributeMaxDynamicSharedMemorySize, LDS_BYTES);
        hipOccupancyMaxActiveBlocksPerMultiprocessor(&per_cu, (const void*)mk_fwd, 512, LDS_BYTES);
        if (per_cu < 1) per_cu = 1;
        if (per_cu > 1) per_cu = 1;
        grid = cus * per_cu;
        (void)hipGetLastError();
    }
    if (grid < 0) return;
    hipMemsetAsync((char*)d_ws + WS_CTL, 0, CTL_BYTES, stream);
    Args a{};
    for (int i = 0; i < 32; ++i) a.in[i] = (const float*)d_in[i];
    a.out = (float*)d_out; a.ws = (unsigned char*)d_ws;
#if MK_SINGLE
    a.ph_lo = 0; a.ph_hi = NPHASE;
    void* args[] = {&a};
    hipError_t e = hipLaunchCooperativeKernel((const void*)mk_fwd, dim3(grid), dim3(512), args, LDS_BYTES, stream);
    if (e != hipSuccess) fprintf(stderr, "cooperative launch failed: %s (grid %d)\n", hipGetErrorString(e), grid);
#else
    for (int ph = 0; ph < NPHASE; ++ph) {
        a.ph_lo = ph; a.ph_hi = ph + 1;
        hipLaunchKernelGGL(mk_fwd, dim3(grid), dim3(512), LDS_BYTES, stream, a);
    }
#endif
}
```
